# Optimizing an MI355X kernel written in HIP

```python
import jax, jax.numpy as jnp
from jax import lax
import numpy as np

D_MODEL = 1024
BATCH = 16
SEQ = 2048
DEPTH = 4
DEC_BATCH = 8
DEC_SEQ = 4096
PAST_LEN = 128

GRID_W = 64
ROPE_THETA = 10000.0
NORM_EPS = 1e-6
NEG_INF = -1e30

MLA_HEADS = 8
MLA_NOPE = 64
MLA_ROPE = 32
MLA_V = 64
MLA_DQK = MLA_NOPE + MLA_ROPE
MLA_Q_RANK = 384
MLA_KV_RANK = 256
MLA_QBLK = 128
MLA_WIDTH = MLA_HEADS * MLA_V

DIL_PAIRS = ((128, 1), (512, 4), (2048, 16))
DIL_GROUPS = 3
DIL_HPG = 4
DIL_HD = 64
DIL_HEADS = DIL_GROUPS * DIL_HPG
DIL_WIDTH = DIL_HPG * DIL_HD

NA_HEADS = 8
NA_HD = 64
NA_KH = 8
NA_KW = 16
NA_WIDTH = NA_HEADS * NA_HD

N_BRANCH = 3
IN_SIZES = (MLA_Q_RANK, MLA_KV_RANK, MLA_ROPE, MLA_WIDTH, 3 * DIL_HEADS * DIL_HD, DIL_WIDTH, 3 * NA_HEADS * NA_HD, NA_WIDTH, N_BRANCH * D_MODEL)
D_IN = 384 + 256 + 32 + 512 + 2304 + 256 + 1536 + 512 + 3072

kernel_name = 'hybrid_mla_dilated_natten_encoder'


def rmsnorm(x, g):
    x32 = x.astype(jnp.float32)
    y = x32 * lax.rsqrt(jnp.mean(x32 * x32, axis=-1, keepdims=True) + NORM_EPS)
    return (y * g.astype(jnp.float32)).astype(x.dtype)


def rope(x, pos):
    half = x.shape[-1] // 2
    inv = ROPE_THETA ** (-jnp.arange(half, dtype=jnp.float32) * 2.0 / x.shape[-1])
    ang = pos[:, None] * inv[None, :]
    cos = jnp.cos(ang)[:, None, :].astype(x.dtype)
    sin = jnp.sin(ang)[:, None, :].astype(x.dtype)
    x1, x2 = x[..., :half], x[..., half:]
    return jnp.concatenate([x1 * cos - x2 * sin, x2 * cos + x1 * sin], axis=-1)


def mla_attention(cq, ckv, kr, g_q, w_uq, g_kv, w_ukv):
    b, s, _ = cq.shape
    pos = jnp.arange(s, dtype=jnp.float32)
    q = (rmsnorm(cq, g_q) @ w_uq).reshape(b, s, MLA_HEADS, MLA_DQK)
    q = jnp.concatenate([q[..., :MLA_NOPE], rope(q[..., MLA_NOPE:], pos)], axis=-1)
    kv = (rmsnorm(ckv, g_kv) @ w_ukv).reshape(b, s, MLA_HEADS, MLA_NOPE + MLA_V)
    k_rope = rope(kr[:, :, None, :], pos)
    k = jnp.concatenate([kv[..., :MLA_NOPE], jnp.broadcast_to(k_rope, (b, s, MLA_HEADS, MLA_ROPE))], axis=-1)
    v = kv[..., MLA_NOPE:]
    scale = MLA_DQK ** -0.5
    qb = q.reshape(b, s // MLA_QBLK, MLA_QBLK, MLA_HEADS, MLA_DQK).transpose(1, 0, 2, 3, 4)

    def block(qi):
        sc = jnp.einsum('bqhd,bkhd->bhqk', qi, k).astype(jnp.float32) * scale
        p = jax.nn.softmax(sc, axis=-1).astype(v.dtype)
        return jnp.einsum('bhqk,bkhd->bqhd', p, v)

    o = lax.map(block, qb)
    return o.transpose(1, 0, 2, 3, 4).reshape(b, s, MLA_WIDTH)


def band_attention(q, k, v, n):
    b, g, L, h, hd = q.shape
    nb = -(-L // n)
    lp = nb * n
    q = jnp.pad(q, ((0, 0), (0, 0), (0, lp - L), (0, 0), (0, 0)))
    pad_kv = ((0, 0), (0, 0), (n, lp - L + n), (0, 0), (0, 0))
    k = jnp.pad(k, pad_kv)
    v = jnp.pad(v, pad_kv)

    def windows(x):
        return jnp.concatenate([x[:, :, j * n:j * n + lp].reshape(b, g, nb, n, h, hd) for j in range(3)], axis=3)

    kw, vw = windows(k), windows(v)
    qb = q.reshape(b, g, nb, n, h, hd)
    sc = jnp.einsum('bgiqhd,bgikhd->bghiqk', qb, kw).astype(jnp.float32) * (hd ** -0.5)
    qpos = jnp.arange(lp).reshape(nb, n)[:, :, None]
    kpos = (jnp.arange(nb) * n - n)[:, None, None] + jnp.arange(3 * n)[None, None, :]
    mask = (jnp.abs(kpos - qpos) <= n) & (kpos >= 0) & (kpos < L)
    sc = jnp.where(mask, sc, NEG_INF)
    lse = jax.nn.logsumexp(sc, axis=-1)
    p = jnp.exp(sc - lse[..., None]).astype(v.dtype)
    o = jnp.einsum('bghiqk,bgikhd->bgiqhd', p, vw).reshape(b, g, lp, h, hd)[:, :, :L]
    lse = lse.reshape(b, g, h, lp).transpose(0, 1, 3, 2)[:, :, :L]
    return o, lse


def dilated_group(q, k, v, d, n):
    b, s, h, hd = q.shape
    L = s // d
    to_cls = lambda x: x.reshape(b, L, d, h, hd).transpose(0, 2, 1, 3, 4)
    o, lse = band_attention(to_cls(q), to_cls(k), to_cls(v), n)
    return o.transpose(0, 2, 1, 3, 4).reshape(b, s, h, hd), lse.transpose(0, 2, 1, 3).reshape(b, s, h)


def dilated_attention(q, k, v):
    b, s = q.shape[0], q.shape[1]
    outs, lses = [], []
    for gi, (w, d) in enumerate(DIL_PAIRS):
        sl = slice(gi * DIL_HPG, (gi + 1) * DIL_HPG)
        o, l = dilated_group(q[:, :, sl], k[:, :, sl], v[:, :, sl], d, w // (2 * d))
        outs.append(o)
        lses.append(l)
    wts = jax.nn.softmax(jnp.stack(lses), axis=0)
    o = jnp.sum(wts[..., None].astype(q.dtype) * jnp.stack(outs), axis=0)
    return o.reshape(b, s, DIL_WIDTH)


def neighbourhood_attention(q, k, v, rpb):
    b, s, h, hd = q.shape
    rows = s // GRID_W
    kh = min(NA_KH, rows)
    qg = q.reshape(b, rows, GRID_W, h, hd)
    r = jnp.arange(rows)
    rs = jnp.clip(r - kh // 2, 0, rows - kh)
    row_idx = rs[:, None] + jnp.arange(kh)[None, :]
    kg = k.reshape(b, rows, GRID_W, h, hd)[:, row_idx]
    vg = v.reshape(b, rows, GRID_W, h, hd)[:, row_idx]
    sc = jnp.einsum('brchd,brjwhd->bhrcjw', qg, kg).astype(jnp.float32) * (hd ** -0.5)
    col = jnp.arange(GRID_W)
    cs = jnp.clip(col - NA_KW // 2, 0, GRID_W - NA_KW)
    colmask = (col[None, :] >= cs[:, None]) & (col[None, :] < cs[:, None] + NA_KW)
    roff = row_idx - r[:, None] + NA_KH - 1
    coff = jnp.clip(col[None, :] - col[:, None] + NA_KW - 1, 0, 2 * NA_KW - 2)
    bias = rpb[:, roff[:, :, None, None], coff[None, None, :, :]].transpose(0, 1, 3, 2, 4)
    sc = jnp.where(colmask[:, None, :], sc + bias[None].astype(jnp.float32), NEG_INF)
    p = jax.nn.softmax(sc.reshape(b, h, rows, GRID_W, kh * GRID_W), axis=-1)
    p = p.reshape(b, h, rows, GRID_W, kh, GRID_W).astype(v.dtype)
    o = jnp.einsum('bhrcjw,brjwhd->brchd', p, vg)
    return o.reshape(b, s, NA_WIDTH)


def encoder_layer(x, c_act, w_ada, b_ada, g_pre, g_post, w_in, g_q, w_uq, g_kv, w_ukv, rpb, w_pa, w_pb, w_pc, w_out):
    b, s, _ = x.shape
    shift, scale, gate = jnp.split(c_act @ w_ada + b_ada, 3, axis=-1)
    h = rmsnorm(x, g_pre) * (1 + scale[:, None, :]) + shift[:, None, :]
    z = h @ w_in
    cuts = [int(c) for c in np.cumsum(IN_SIZES)[:-1]]
    cq, ckv, kr, gate_a, qkv_b, gate_b, qkv_c, gate_c, merge = jnp.split(z, cuts, axis=-1)
    o_a = mla_attention(cq, ckv, kr, g_q, w_uq, g_kv, w_ukv)
    pos = jnp.arange(s, dtype=jnp.float32)
    qkv_b = qkv_b.reshape(b, s, 3, DIL_HEADS, DIL_HD)
    o_b = dilated_attention(rope(qkv_b[:, :, 0], pos), rope(qkv_b[:, :, 1], pos), qkv_b[:, :, 2])
    qkv_c = qkv_c.reshape(b, s, 3, NA_HEADS, NA_HD)
    o_c = neighbourhood_attention(qkv_c[:, :, 0], qkv_c[:, :, 1], qkv_c[:, :, 2], rpb)
    p_a = (o_a * jax.nn.silu(gate_a)) @ w_pa
    p_b = (o_b * jax.nn.silu(gate_b)) @ w_pb
    p_c = (o_c * jax.nn.silu(gate_c)) @ w_pc
    mg = jax.nn.sigmoid(merge.reshape(b, s, N_BRANCH, D_MODEL))
    mixed = mg[:, :, 0] * p_a + mg[:, :, 1] * p_b + mg[:, :, 2] * p_c
    out = mixed @ w_out
    return x + gate[:, None, :] * rmsnorm(out, g_post)


def trunk(x, c, w_ada, b_ada, g_pre, g_post, w_in, g_q, w_uq, g_kv, w_ukv, rpb, w_pa, w_pb, w_pc, w_out):
    c_act = jax.nn.silu(c)
    for l in range(DEPTH):
        x = encoder_layer(x, c_act, w_ada[l], b_ada[l], g_pre[l], g_post[l], w_in[l], g_q[l], w_uq[l],
                          g_kv[l], w_ukv[l], rpb[l], w_pa[l], w_pb[l], w_pc[l], w_out[l])
    return x


def setup_inputs(seed: int = 0) -> dict:
    key = jax.random.key(seed)
    ks = jax.random.split(key, 18)
    f32 = jnp.float32
    nrm = lambda k, shape, sc: jax.random.normal(k, shape, f32) * sc
    return {
        'x_prompt': nrm(ks[0], (BATCH, SEQ, D_MODEL), 1.0),
        'x_sample': nrm(ks[1], (DEC_BATCH, DEC_SEQ, D_MODEL), 1.0),
        'c_prompt': nrm(ks[2], (BATCH, D_MODEL), 1.0),
        'c_sample': nrm(ks[3], (DEC_BATCH, D_MODEL), 1.0),
        'w_ada': nrm(ks[4], (DEPTH, D_MODEL, 3 * D_MODEL), 0.5 * D_MODEL ** -0.5),
        'b_ada': nrm(ks[5], (DEPTH, 3 * D_MODEL), 0.01),
        'g_pre': 1.0 + nrm(ks[6], (DEPTH, D_MODEL), 0.02),
        'g_post': 1.0 + nrm(ks[7], (DEPTH, D_MODEL), 0.02),
        'w_in': nrm(ks[8], (DEPTH, D_MODEL, D_IN), D_MODEL ** -0.5),
        'g_q': 1.0 + nrm(ks[9], (DEPTH, MLA_Q_RANK), 0.02),
        'w_uq': nrm(ks[10], (DEPTH, MLA_Q_RANK, MLA_HEADS * MLA_DQK), MLA_Q_RANK ** -0.5),
        'g_kv': 1.0 + nrm(ks[11], (DEPTH, MLA_KV_RANK), 0.02),
        'w_ukv': nrm(ks[12], (DEPTH, MLA_KV_RANK, MLA_HEADS * (MLA_NOPE + MLA_V)), MLA_KV_RANK ** -0.5),
        'rpb': nrm(ks[13], (DEPTH, NA_HEADS, 2 * NA_KH - 1, 2 * NA_KW - 1), 0.1),
        'w_pa': nrm(ks[14], (DEPTH, MLA_WIDTH, D_MODEL), MLA_WIDTH ** -0.5),
        'w_pb': nrm(ks[15], (DEPTH, DIL_WIDTH, D_MODEL), DIL_WIDTH ** -0.5),
        'w_pc': nrm(ks[16], (DEPTH, NA_WIDTH, D_MODEL), NA_WIDTH ** -0.5),
        'w_out': nrm(ks[17], (DEPTH, D_MODEL, D_MODEL), D_MODEL ** -0.5),
    }


def reference(x_prompt, x_sample, c_prompt, c_sample, w_ada, b_ada, g_pre, g_post, w_in, g_q, w_uq, g_kv, w_ukv, rpb, w_pa, w_pb, w_pc, w_out):
    y_prompt = trunk(x_prompt, c_prompt, w_ada, b_ada, g_pre, g_post, w_in, g_q, w_uq, g_kv, w_ukv, rpb, w_pa, w_pb, w_pc, w_out)
    y_sample = trunk(x_sample, c_sample, w_ada, b_ada, g_pre, g_post, w_in, g_q, w_uq, g_kv, w_ukv, rpb, w_pa, w_pb, w_pc, w_out)
    return (y_prompt, y_sample)
```

```cpp
#include <hip/hip_runtime.h>
#include <hip/hip_cooperative_groups.h>
#include <stdint.h>
#include <string.h>
#include <stdio.h>
namespace cg = cooperative_groups;

typedef unsigned short u16;
typedef short bf16x8 __attribute__((ext_vector_type(8)));
typedef short s16x4 __attribute__((ext_vector_type(4)));
typedef float f32x16 __attribute__((ext_vector_type(16)));
typedef uint32_t u32x4 __attribute__((ext_vector_type(4)));
typedef __bf16 bf2_t __attribute__((ext_vector_type(2)));
typedef float f2_t __attribute__((ext_vector_type(2)));
#define DI __device__ __forceinline__
#define LDSP __attribute__((address_space(3)))

constexpr int DM = 1024;
constexpr int DEPTH = 4;
constexpr int NPTOK = 32768;
constexpr int NTOK = 65536;
constexpr int CT = 16384;
constexpr int NCHUNK = NTOK / CT;
constexpr int NIN = 8960;
constexpr int D_IN = 8864;
constexpr float EPS = 1e-6f;
constexpr float LOG2E = 1.4426950408889634f;
constexpr float QS_A = 0.10206207261596577f * LOG2E;
constexpr float QS_64 = 0.125f * LOG2E;
constexpr float NEGBIG = -1e30f;

constexpr int SEC_QKVB = 0, SEC_QKVC = 2304, SEC_MG = 3840, SEC_GA = 6912, SEC_GB = 7424, SEC_GC = 7680,
              SEC_CQ = 8192, SEC_CKV = 8576, SEC_KR = 8832, SEC_PAD = 8896;

struct Params {
  const float *x_prompt, *x_sample, *c_prompt, *c_sample, *w_ada, *b_ada, *g_pre, *g_post, *w_in, *g_q, *w_uq, *g_kv,
      *w_ukv, *rpb, *w_pa, *w_pb, *w_pc, *w_out;
  float* out;
  u16 *wt_in, *wt_uq, *wt_ukv, *wt_pa, *wt_pb, *wt_pc, *wt_out;
  float* mod;
  float2* ropeB;
  float2* ropeA;
  u16* hbuf;
  u16* qa;
  u16* qkvb;
  float* outb;
  u16* qkvc;
  u16* mixed;
  u16* mg;
  u16 *ga, *gb, *gc;
  u16 *cq, *ckv;
  u16 *ka, *va;
  u16* ob;
  float* lseb;
};

DI uint32_t pack2(float a, float b) {
  f2_t v = {a, b};
  bf2_t r = __builtin_convertvector(v, bf2_t);
  return __builtin_bit_cast(uint32_t, r);
}
DI float bflo(uint32_t u) { return __uint_as_float(u << 16); }
DI float bfhi(uint32_t u) { return __uint_as_float(u & 0xffff0000u); }
DI void st4(u16* dst, float a, float b, float c, float d) {
  uint2 v;
  v.x = pack2(a, b);
  v.y = pack2(c, d);
  *(uint2*)dst = v;
}
DI float sigmoidf_(float x) { return 1.f / (1.f + __expf(-x)); }
DI float siluf_(float x) { return x / (1.f + __expf(-x)); }
DI int get_tid() { int t = threadIdx.x; asm volatile("" : "+v"(t)); return t; }
DI int crow(int reg, int h) { return (reg & 3) + 8 * (reg >> 2) + 4 * h; }
DI f32x16 mfma(bf16x8 a, bf16x8 b, f32x16 c) { return __builtin_amdgcn_mfma_f32_32x32x16_bf16(a, b, c, 0, 0, 0); }
DI float wave_sum(float v) {
#pragma unroll
  for (int o = 32; o > 0; o >>= 1) v += __shfl_xor(v, o);
  return v;
}

constexpr int GSTR = 72;
template <int MTN>
DI void gemm_core(f32x16 (&acc)[2][MTN], const u16* __restrict__ Wt, int ldw, const u16* __restrict__ Act, int lda, int K,
                  u16* smW, u16* smA) {
  const int tid = get_tid(), lane = tid & 63, wv = tid >> 6, wm = wv & 1, wn = wv >> 1, r = lane & 31, h = lane >> 5;
  const int lr = tid >> 3, lc = (tid & 7) * 8;
  u32x4 rw[4], ra[2 * MTN];
  const u16* wp = Wt + (size_t)lr * ldw + lc;
  const u16* ap = Act + (size_t)lr * lda + lc;
#pragma unroll
  for (int i = 0; i < 4; ++i) rw[i] = *(const u32x4*)(wp + (size_t)(32 * i) * ldw);
#pragma unroll
  for (int i = 0; i < 2 * MTN; ++i) ra[i] = *(const u32x4*)(ap + (size_t)(32 * i) * lda);
  for (int k0 = 0; k0 < K; k0 += 64) {
    __syncthreads();
#pragma unroll
    for (int i = 0; i < 4; ++i) *(u32x4*)(smW + (lr + 32 * i) * GSTR + lc) = rw[i];
#pragma unroll
    for (int i = 0; i < 2 * MTN; ++i) *(u32x4*)(smA + (lr + 32 * i) * GSTR + lc) = ra[i];
    __syncthreads();
    if (k0 + 64 < K) {
#pragma unroll
      for (int i = 0; i < 4; ++i) rw[i] = *(const u32x4*)(wp + (size_t)(32 * i) * ldw + k0 + 64);
#pragma unroll
      for (int i = 0; i < 2 * MTN; ++i) ra[i] = *(const u32x4*)(ap + (size_t)(32 * i) * lda + k0 + 64);
    }
#pragma unroll
    for (int ks = 0; ks < 4; ++ks) {
      bf16x8 af[2], bfr[MTN];
#pragma unroll
      for (int t = 0; t < 2; ++t) af[t] = *(const bf16x8*)(smW + (wn * 64 + t * 32 + r) * GSTR + ks * 16 + 8 * h);
#pragma unroll
      for (int t = 0; t < MTN; ++t) bfr[t] = *(const bf16x8*)(smA + (wm * 32 * MTN + t * 32 + r) * GSTR + ks * 16 + 8 * h);
#pragma unroll
      for (int nt = 0; nt < 2; ++nt)
#pragma unroll
        for (int mt = 0; mt < MTN; ++mt) acc[nt][mt] = mfma(af[nt], bfr[mt], acc[nt][mt]);
    }
  }
}
template <int MTN>
DI void zero_acc(f32x16 (&acc)[2][MTN]) {
#pragma unroll
  for (int a = 0; a < 2; ++a)
#pragma unroll
    for (int b = 0; b < MTN; ++b)
#pragma unroll
      for (int i = 0; i < 16; ++i) acc[a][b][i] = 0.f;
}

DI int inproj_orig_col(int np) {
  if (np < SEC_QKVC) return 1184 + np;
  if (np < SEC_MG) return 3744 + (np - SEC_QKVC);
  if (np < SEC_GA) return 5792 + (np - SEC_MG);
  if (np < SEC_GB) return 672 + (np - SEC_GA);
  if (np < SEC_GC) return 3488 + (np - SEC_GB);
  if (np < SEC_CQ) return 5280 + (np - SEC_GC);
  if (np < SEC_CKV) return 0 + (np - SEC_CQ);
  if (np < SEC_KR) return 384 + (np - SEC_CKV);
  if (np < SEC_KR + 32) return 640 + (np - SEC_KR);
  return -1;
}
DI void conv_tile(const float* __restrict__ src, int N, int ncol0, int k0, const float* __restrict__ kscale,
                  u16* __restrict__ dst, int K, int nrow0, float* tl) {
  const int tid = get_tid(), kk = tid >> 5, nn = tid & 31;
  __syncthreads();
#pragma unroll
  for (int i = 0; i < 4; ++i) {
    int k = kk + 8 * i;
    float v = 0.f;
    if (ncol0 >= 0) {
      v = src[(size_t)(k0 + k) * N + ncol0 + nn];
      if (kscale) v *= kscale[k0 + k];
    }
    tl[k * 33 + nn] = v;
  }
  __syncthreads();
#pragma unroll
  for (int i = 0; i < 4; ++i) {
    int n = kk + 8 * i;
    float v = tl[nn * 33 + n];
    dst[(size_t)(nrow0 + n) * K + k0 + nn] = (u16)(pack2(v, 0.f) & 0xffffu);
  }
}
constexpr int CONV_PER_LAYER = 8960 + 288 + 256 + 512 + 256 + 512 + 1024;
constexpr int NCONV = CONV_PER_LAYER * DEPTH;
constexpr int NADA = DEPTH * 96;
constexpr int NROPE = 4096 * 48 / 256;

DI void phase_prep(const Params& p, char* smem) {
  const int tid = get_tid();
  float* fl = (float*)smem;
  for (int job = blockIdx.x; job < NCONV + NADA + NROPE; job += gridDim.x) {
    if (job < NCONV) {
      int l = job / CONV_PER_LAYER, j = job % CONV_PER_LAYER;
      if (j < 8960) {
        int nt = j >> 5, kt = j & 31;
        conv_tile(p.w_in + (size_t)l * DM * D_IN, D_IN, inproj_orig_col(nt * 32), kt * 32, nullptr,
                  p.wt_in + (size_t)l * NIN * DM, DM, nt * 32, fl);
      } else if ((j -= 8960) < 288) {
        int nt = j / 12, kt = j % 12;
        conv_tile(p.w_uq + (size_t)l * 384 * 768, 768, nt * 32, kt * 32, p.g_q + l * 384, p.wt_uq + (size_t)l * 768 * 384,
                  384, nt * 32, fl);
      } else if ((j -= 288) < 256) {
        int nt = j / 8, kt = j % 8;
        conv_tile(p.w_ukv + (size_t)l * 256 * 1024, 1024, nt * 32, kt * 32, p.g_kv + l * 256,
                  p.wt_ukv + (size_t)l * 1024 * 256, 256, nt * 32, fl);
      } else if ((j -= 256) < 512) {
        int nt = j / 16, kt = j % 16;
        conv_tile(p.w_pa + (size_t)l * 512 * 1024, 1024, nt * 32, kt * 32, nullptr, p.wt_pa + (size_t)l * 1024 * 512, 512,
                  nt * 32, fl);
      } else if ((j -= 512) < 256) {
        int nt = j / 8, kt = j % 8;
        conv_tile(p.w_pb + (size_t)l * 256 * 1024, 1024, nt * 32, kt * 32, nullptr, p.wt_pb + (size_t)l * 1024 * 256, 256,
                  nt * 32, fl);
      } else if ((j -= 256) < 512) {
        int nt = j / 16, kt = j % 16;
        conv_tile(p.w_pc + (size_t)l * 512 * 1024, 1024, nt * 32, kt * 32, nullptr, p.wt_pc + (size_t)l * 1024 * 512, 512,
                  nt * 32, fl);
      } else {
        j -= 512;
        int nt = j / 32, kt = j % 32;
        conv_tile(p.w_out + (size_t)l * 1024 * 1024, 1024, nt * 32, kt * 32, nullptr, p.wt_out + (size_t)l * 1024 * 1024,
                  1024, nt * 32, fl);
      }
    } else if (job < NCONV + NADA) {
      int jb = job - NCONV;
      int l = jb / 96, j0 = (jb % 96) * 32;
      int jj = tid & 31, kp = tid >> 5;
      float* cs = fl;
      float* red = fl + 24 * 128;
      float acc[24];
#pragma unroll
      for (int b = 0; b < 24; ++b) acc[b] = 0.f;
      const float* W = p.w_ada + (size_t)l * DM * 3072 + j0 + jj;
      for (int ch = 0; ch < 8; ++ch) {
        __syncthreads();
        for (int e = tid; e < 24 * 128; e += 256) {
          int b = e >> 7, kk = e & 127;
          float cv = (b < 16) ? p.c_prompt[b * DM + ch * 128 + kk] : p.c_sample[(b - 16) * DM + ch * 128 + kk];
          cs[e] = siluf_(cv);
        }
        __syncthreads();
#pragma unroll 4
        for (int kk = kp * 16; kk < kp * 16 + 16; ++kk) {
          float w = W[(size_t)(ch * 128 + kk) * 3072];
#pragma unroll
          for (int b = 0; b < 24; ++b) acc[b] += cs[b * 128 + kk] * w;
        }
      }
      __syncthreads();
#pragma unroll
      for (int b = 0; b < 24; ++b) red[(kp * 24 + b) * 32 + jj] = acc[b];
      __syncthreads();
      for (int e = tid; e < 24 * 32; e += 256) {
        int b = e >> 5, j = e & 31;
        float s = 0.f;
#pragma unroll
        for (int q = 0; q < 8; ++q) s += red[(q * 24 + b) * 32 + j];
        p.mod[((size_t)l * 24 + b) * 3072 + j0 + j] = s + p.b_ada[l * 3072 + j0 + j];
      }
    } else {
      int e = (job - NCONV - NADA) * 256 + tid;
      int pos = e / 48, f = e % 48;
      double base, inv = 1.0;
      int ex;
      if (f < 32) { base = 0.7498942093324559; ex = f; }
      else { base = 0.5623413251903491; ex = f - 32; }
      for (int i = 0; i < ex; ++i) inv *= base;
      double ang = (double)pos * inv;
      double n = rint(ang * 0.15915494309189535);
      float rr = (float)(ang - n * 6.283185307179586);
      float2 cs2 = make_float2(__cosf(rr), __sinf(rr));
      if (f < 32) p.ropeB[pos * 32 + f] = cs2;
      else p.ropeA[pos * 16 + (f - 32)] = cs2;
    }
  }
}

DI const float* x_row_in(const Params& p, int t) {
  return (t < NPTOK) ? p.x_prompt + (size_t)t * DM : p.x_sample + (size_t)(t - NPTOK) * DM;
}
DI void write_h(const Params& p, int l, int b, int tl, int lane, const float (&y)[16]) {
  float ss = 0.f;
#pragma unroll
  for (int i = 0; i < 16; ++i) ss += y[i] * y[i];
  ss = wave_sum(ss);
  float rinv = rsqrtf(ss * (1.f / DM) + EPS);
  const float* md = p.mod + ((size_t)l * 24 + b) * 3072;
#pragma unroll
  for (int i = 0; i < 4; ++i) {
    int col = 4 * lane + 256 * i;
    float4 g = *(const float4*)(p.g_pre + l * DM + col);
    float4 sh = *(const float4*)(md + col);
    float4 sc = *(const float4*)(md + 1024 + col);
    st4(p.hbuf + (size_t)tl * DM + col, y[4 * i + 0] * rinv * g.x * (1.f + sc.x) + sh.x,
        y[4 * i + 1] * rinv * g.y * (1.f + sc.y) + sh.y, y[4 * i + 2] * rinv * g.z * (1.f + sc.z) + sh.z,
        y[4 * i + 3] * rinv * g.w * (1.f + sc.w) + sh.w);
  }
}
DI void phase_norm0(const Params& p, int c, int S, int bbase) {
  const int tid_ = get_tid(); const int lane = tid_ & 63, wv = tid_ >> 6;
  for (int tl = blockIdx.x * 4 + wv; tl < CT; tl += gridDim.x * 4) {
    const float* xr = x_row_in(p, c * CT + tl);
    float y[16];
#pragma unroll
    for (int i = 0; i < 4; ++i) {
      float4 v = *(const float4*)(xr + 4 * lane + 256 * i);
      y[4 * i] = v.x; y[4 * i + 1] = v.y; y[4 * i + 2] = v.z; y[4 * i + 3] = v.w;
    }
    write_h(p, 0, bbase + tl / S, tl, lane, y);
  }
}
DI void phase_post(const Params& p, int c, int l, int S, int bbase) {
  const int tid_ = get_tid(); const int lane = tid_ & 63, wv = tid_ >> 6;
  for (int tl = blockIdx.x * 4 + wv; tl < CT; tl += gridDim.x * 4) {
    const int t = c * CT + tl, b = bbase + tl / S;
    const float* xr = (l == 0) ? x_row_in(p, t) : p.out + (size_t)t * DM;
    const float* orow = p.outb + (size_t)tl * DM;
    float o[16], y[16];
    float ss = 0.f;
#pragma unroll
    for (int i = 0; i < 4; ++i) {
      float4 v = *(const float4*)(orow + 4 * lane + 256 * i);
      o[4 * i] = v.x; o[4 * i + 1] = v.y; o[4 * i + 2] = v.z; o[4 * i + 3] = v.w;
      ss += v.x * v.x + v.y * v.y + v.z * v.z + v.w * v.w;
    }
    ss = wave_sum(ss);
    float rinv = rsqrtf(ss * (1.f / DM) + EPS);
    const float* md = p.mod + ((size_t)l * 24 + b) * 3072 + 2048;
#pragma unroll
    for (int i = 0; i < 4; ++i) {
      int col = 4 * lane + 256 * i;
      float4 xv = *(const float4*)(xr + col);
      float4 g = *(const float4*)(p.g_post + l * DM + col);
      float4 gt = *(const float4*)(md + col);
      float4 yv;
      yv.x = xv.x + gt.x * (o[4 * i] * rinv * g.x);
      yv.y = xv.y + gt.y * (o[4 * i + 1] * rinv * g.y);
      yv.z = xv.z + gt.z * (o[4 * i + 2] * rinv * g.z);
      yv.w = xv.w + gt.w * (o[4 * i + 3] * rinv * g.w);
      *(float4*)(p.out + (size_t)t * DM + col) = yv;
      y[4 * i] = yv.x; y[4 * i + 1] = yv.y; y[4 * i + 2] = yv.z; y[4 * i + 3] = yv.w;
    }
    if (l + 1 < DEPTH) write_h(p, l + 1, b, tl, lane, y);
  }
}

DI void phase_inproj(const Params& p, int l, int S, char* smem) {
  u16* smW = (u16*)smem;
  u16* smA = smW + 128 * GSTR;
  const int tid = get_tid(), lane = tid & 63, wv = tid >> 6, wm = wv & 1, wn = wv >> 1, r = lane & 31, h = lane >> 5;
  const u16* W = p.wt_in + (size_t)l * NIN * DM;
  constexpr int MT = CT / 128, NT = NIN / 128;
  for (int tile = blockIdx.x; tile < MT * NT; tile += gridDim.x) {
    const int n0 = (tile / MT) * 128, m0 = (tile % MT) * 128;
    f32x16 acc[2][2];
    zero_acc<2>(acc);
    gemm_core<2>(acc, W + (size_t)n0 * DM, DM, p.hbuf + (size_t)m0 * DM, DM, DM, smW, smA);
    const int nbase = n0 + wn * 64;
#pragma unroll
    for (int mt = 0; mt < 2; ++mt) {
      const int tl = m0 + wm * 64 + mt * 32 + r;
      const int pos = tl & (S - 1);
      if (nbase < SEC_QKVC) {
        const int which = nbase / 768;
        u16* dst = p.qkvb + (size_t)tl * 2304 + nbase;
        if (which < 2) {
          const float sc = (which == 0) ? QS_64 : 1.f;
          const float4* tab = (const float4*)(p.ropeB + (size_t)pos * 32);
#pragma unroll
          for (int g = 0; g < 4; ++g) {
            float4 t0 = tab[4 * g + 2 * h], t1 = tab[4 * g + 2 * h + 1];
            float cc[4] = {t0.x, t0.z, t1.x, t1.z}, sn[4] = {t0.y, t0.w, t1.y, t1.w};
            float y1[4], y2[4];
#pragma unroll
            for (int i = 0; i < 4; ++i) {
              float x1 = acc[0][mt][4 * g + i], x2 = acc[1][mt][4 * g + i];
              y1[i] = (x1 * cc[i] - x2 * sn[i]) * sc;
              y2[i] = (x2 * cc[i] + x1 * sn[i]) * sc;
            }
            st4(dst + 8 * g + 4 * h, y1[0], y1[1], y1[2], y1[3]);
            st4(dst + 32 + 8 * g + 4 * h, y2[0], y2[1], y2[2], y2[3]);
          }
        } else {
#pragma unroll
          for (int nt = 0; nt < 2; ++nt)
#pragma unroll
            for (int g = 0; g < 4; ++g)
              st4(dst + nt * 32 + 8 * g + 4 * h, acc[nt][mt][4 * g], acc[nt][mt][4 * g + 1], acc[nt][mt][4 * g + 2],
                  acc[nt][mt][4 * g + 3]);
        }
      } else if (nbase < SEC_MG) {
        const int i0 = nbase - SEC_QKVC;
        const float sc = (i0 < 512) ? QS_64 : 1.f;
        u16* dst = p.qkvc + (size_t)tl * 1536 + i0;
#pragma unroll
        for (int nt = 0; nt < 2; ++nt)
#pragma unroll
          for (int g = 0; g < 4; ++g)
            st4(dst + nt * 32 + 8 * g + 4 * h, acc[nt][mt][4 * g] * sc, acc[nt][mt][4 * g + 1] * sc,
                acc[nt][mt][4 * g + 2] * sc, acc[nt][mt][4 * g + 3] * sc);
      } else if (nbase < SEC_GA) {
        u16* dst = p.mg + (size_t)tl * 3072 + (nbase - SEC_MG);
#pragma unroll
        for (int nt = 0; nt < 2; ++nt)
#pragma unroll
          for (int g = 0; g < 4; ++g)
            st4(dst + nt * 32 + 8 * g + 4 * h, sigmoidf_(acc[nt][mt][4 * g]), sigmoidf_(acc[nt][mt][4 * g + 1]),
                sigmoidf_(acc[nt][mt][4 * g + 2]), sigmoidf_(acc[nt][mt][4 * g + 3]));
      } else if (nbase < SEC_CQ) {
        u16* dst;
        if (nbase < SEC_GB) dst = p.ga + (size_t)tl * 512 + (nbase - SEC_GA);
        else if (nbase < SEC_GC) dst = p.gb + (size_t)tl * 256 + (nbase - SEC_GB);
        else dst = p.gc + (size_t)tl * 512 + (nbase - SEC_GC);
#pragma unroll
        for (int nt = 0; nt < 2; ++nt)
#pragma unroll
          for (int g = 0; g < 4; ++g)
            st4(dst + nt * 32 + 8 * g + 4 * h, siluf_(acc[nt][mt][4 * g]), siluf_(acc[nt][mt][4 * g + 1]),
                siluf_(acc[nt][mt][4 * g + 2]), siluf_(acc[nt][mt][4 * g + 3]));
      } else if (nbase < SEC_KR) {
        u16* dst;
        if (nbase < SEC_CKV) dst = p.cq + (size_t)tl * 384 + (nbase - SEC_CQ);
        else dst = p.ckv + (size_t)tl * 256 + (nbase - SEC_CKV);
#pragma unroll
        for (int nt = 0; nt < 2; ++nt)
#pragma unroll
          for (int g = 0; g < 4; ++g)
            st4(dst + nt * 32 + 8 * g + 4 * h, acc[nt][mt][4 * g], acc[nt][mt][4 * g + 1], acc[nt][mt][4 * g + 2],
                acc[nt][mt][4 * g + 3]);
      } else if (nbase == SEC_KR) {
        const float4* tab = (const float4*)(p.ropeA + (size_t)pos * 16);
        float y[16];
#pragma unroll
        for (int g = 0; g < 2; ++g) {
          float4 t0 = tab[4 * g + 2 * h], t1 = tab[4 * g + 2 * h + 1];
          float cc[4] = {t0.x, t0.z, t1.x, t1.z}, sn[4] = {t0.y, t0.w, t1.y, t1.w};
#pragma unroll
          for (int i = 0; i < 4; ++i) {
            float x1 = acc[0][mt][4 * g + i], x2 = acc[0][mt][4 * g + 8 + i];
            y[4 * g + i] = x1 * cc[i] - x2 * sn[i];
            y[4 * g + 8 + i] = x2 * cc[i] + x1 * sn[i];
          }
        }
        u16* dst = p.ka + (size_t)tl * 768 + 64;
#pragma unroll
        for (int hd = 0; hd < 8; ++hd)
#pragma unroll
          for (int g = 0; g < 4; ++g) st4(dst + hd * 96 + 8 * g + 4 * h, y[4 * g], y[4 * g + 1], y[4 * g + 2], y[4 * g + 3]);
      }
    }
  }
}

DI void phase_upproj(const Params& p, int l, int S, char* smem) {
  u16* smW = (u16*)smem;
  u16* smA = smW + 128 * GSTR;
  float* rinv = (float*)(smA + 128 * GSTR);
  const int tid = get_tid(), lane = tid & 63, wv = tid >> 6, wm = wv & 1, wn = wv >> 1, r = lane & 31, h = lane >> 5;
  constexpr int MT = CT / 128;
  for (int tile = blockIdx.x; tile < MT * 14; tile += gridDim.x) {
    const int ntile = tile / MT, m0 = (tile % MT) * 128;
    const bool isq = ntile < 6;
    const int n0 = (isq ? ntile : ntile - 6) * 128;
    const int K = isq ? 384 : 256;
    const u16* A = isq ? p.cq + (size_t)m0 * 384 : p.ckv + (size_t)m0 * 256;
    const u16* W = isq ? p.wt_uq + (size_t)l * 768 * 384 + (size_t)n0 * 384 : p.wt_ukv + (size_t)l * 1024 * 256 + (size_t)n0 * 256;
    __syncthreads();
    {
      const int row = tid >> 1, half = tid & 1, kh = K >> 1;
      const u16* ar = A + (size_t)row * K + half * kh;
      float ss = 0.f;
      for (int k = 0; k < kh; k += 8) {
        uint4 v = *(const uint4*)(ar + k);
        float a;
        a = bflo(v.x); ss += a * a; a = bfhi(v.x); ss += a * a;
        a = bflo(v.y); ss += a * a; a = bfhi(v.y); ss += a * a;
        a = bflo(v.z); ss += a * a; a = bfhi(v.z); ss += a * a;
        a = bflo(v.w); ss += a * a; a = bfhi(v.w); ss += a * a;
      }
      ss += __shfl_xor(ss, 1);
      if (half == 0) rinv[row] = rsqrtf(ss / (float)K + EPS);
    }
    f32x16 acc[2][2];
    zero_acc<2>(acc);
    gemm_core<2>(acc, W, K, A, K, K, smW, smA);
    const int nbase = n0 + wn * 64;
#pragma unroll
    for (int mt = 0; mt < 2; ++mt) {
      const int rl = wm * 64 + mt * 32 + r;
      const int tl = m0 + rl;
      const float ri = rinv[rl];
      if (isq) {
        const int pos = tl & (S - 1);
        const float sc = ri * QS_A;
#pragma unroll
        for (int nt = 0; nt < 2; ++nt) {
          const int c0 = nbase + nt * 32;
          u16* dst = p.qa + (size_t)tl * 768 + c0;
          if ((c0 % 96) == 64) {
            const float4* tab = (const float4*)(p.ropeA + (size_t)pos * 16);
            float y[16];
#pragma unroll
            for (int g = 0; g < 2; ++g) {
              float4 t0 = tab[4 * g + 2 * h], t1 = tab[4 * g + 2 * h + 1];
              float cc[4] = {t0.x, t0.z, t1.x, t1.z}, sn[4] = {t0.y, t0.w, t1.y, t1.w};
#pragma unroll
              for (int i = 0; i < 4; ++i) {
                float x1 = acc[nt][mt][4 * g + i], x2 = acc[nt][mt][4 * g + 8 + i];
                y[4 * g + i] = (x1 * cc[i] - x2 * sn[i]) * sc;
                y[4 * g + 8 + i] = (x2 * cc[i] + x1 * sn[i]) * sc;
              }
            }
#pragma unroll
            for (int g = 0; g < 4; ++g) st4(dst + 8 * g + 4 * h, y[4 * g], y[4 * g + 1], y[4 * g + 2], y[4 * g + 3]);
          } else {
#pragma unroll
            for (int g = 0; g < 4; ++g)
              st4(dst + 8 * g + 4 * h, acc[nt][mt][4 * g] * sc, acc[nt][mt][4 * g + 1] * sc, acc[nt][mt][4 * g + 2] * sc,
                  acc[nt][mt][4 * g + 3] * sc);
          }
        }
      } else {
#pragma unroll
        for (int nt = 0; nt < 2; ++nt) {
          const int c0 = nbase + nt * 32;
          const int hd = c0 >> 7, e0 = c0 & 127;
          u16* dst = (e0 < 64) ? p.ka + (size_t)tl * 768 + hd * 96 + e0 : p.va + (size_t)tl * 512 + hd * 64 + (e0 - 64);
#pragma unroll
          for (int g = 0; g < 4; ++g)
            st4(dst + 8 * g + 4 * h, acc[nt][mt][4 * g] * ri, acc[nt][mt][4 * g + 1] * ri, acc[nt][mt][4 * g + 2] * ri,
                acc[nt][mt][4 * g + 3] * ri);
        }
      }
    }
  }
}

constexpr int VSTR = 72;
template <int MODE>
DI void attn_item(const Params& p, int item, int l, int S, char* smem) {
  constexpr int DQK = (MODE == 0) ? 96 : 64;
  constexpr int KSTR = DQK + 8;
  constexpr int NKS = DQK / 16;
  constexpr int KCH = DQK / 8;
  constexpr int NKL = KCH * 64 / 256;
  u16* Ks = (u16*)smem;
  u16* Vs = (u16*)(smem + 64 * 104 * 2);
  float* bias = (float*)(smem + 64 * 104 * 2 + 64 * VSTR * 2);
  const int tid = get_tid(), lane = tid & 63, w = tid >> 6, r = lane & 31, h = lane >> 5;

  int tb, nkt;
  const u16 *Qp, *Kb, *Vb;
  int kld, vld;
  int tlq;
  int dd = 1, L = 0, rc = 0, qb = 0, grp = 0, hj = 0;
  int rows = 0, rsU = 0, qr = 0, qc = 0, rsq = 0, csq = 0, hd = 0;
  if constexpr (MODE == 0) {
    const int nqb = S / 128;
    const int per_seq = nqb * 8;
    const int s = item / per_seq, rem = item % per_seq;
    hd = rem / nqb;
    const int qblk = rem % nqb;
    tb = s * S;
    tlq = tb + qblk * 128 + 32 * w + r;
    Qp = p.qa + (size_t)tlq * 768 + hd * 96;
    Kb = p.ka + hd * 96; kld = 768;
    Vb = p.va + hd * 64; vld = 512;
    nkt = S / 64;
  } else if constexpr (MODE == 1) {
    const int nb = S / 128;
    const int per_seq = 12 * nb;
    const int s = item / per_seq, rem = item % per_seq;
    const int hh = rem / nb, cb = rem % nb;
    grp = hh >> 2; hj = hh & 3;
    dd = (grp == 0) ? 1 : (grp == 1 ? 4 : 16);
    L = S / dd;
    const int nqb = L / 128;
    rc = cb / nqb; qb = cb % nqb;
    tb = s * S;
    tlq = tb + rc + dd * (qb * 128 + 32 * w + r);
    Qp = p.qkvb + (size_t)tlq * 2304 + hh * 64;
    Kb = p.qkvb + 768 + hh * 64; kld = 2304;
    Vb = p.qkvb + 1536 + hh * 64; vld = 2304;
    nkt = 4;
  } else {
    rows = S / 64;
    const int nrp = rows / 2;
    const int per_seq = 8 * nrp;
    const int s = item / per_seq, rem = item % per_seq;
    hd = rem / nrp;
    const int R = rem % nrp;
    tb = s * S;
    qr = 2 * R + (w >> 1); qc = 32 * (w & 1) + r;
    tlq = tb + qr * 64 + qc;
    rsU = min(max(2 * R - 4, 0), rows - 8);
    rsq = min(max(qr - 4, 0), rows - 8);
    csq = min(max(qc - 8, 0), 48);
    Qp = p.qkvc + (size_t)tlq * 1536 + hd * 64;
    Kb = p.qkvc + 512 + hd * 64; kld = 1536;
    Vb = p.qkvc + 1024 + hd * 64; vld = 1536;
    nkt = 9;
  }

  __syncthreads();
  if constexpr (MODE == 2) {
    const float* bsrc = p.rpb + ((size_t)l * 8 + hd) * 465;
    for (int e = tid; e < 465; e += 256) bias[e] = bsrc[e] * LOG2E;
  }

  bf16x8 qf[NKS];
#pragma unroll
  for (int ks = 0; ks < NKS; ++ks) qf[ks] = *(const bf16x8*)(Qp + 16 * ks + 8 * h);

  u32x4 kreg[NKL], vreg[2];
  auto key_tok = [&](int kt, int kk) -> int {
    if constexpr (MODE == 0) return tb + kt * 64 + kk;
    else if constexpr (MODE == 1) {
      int km = qb * 128 - 64 + kt * 64 + kk;
      km = min(max(km, 0), L - 1);
      return tb + rc + dd * km;
    } else {
      int krow = min(rsU + kt, rows - 1);
      return tb + krow * 64 + kk;
    }
  };
  auto load_tile = [&](int kt) {
#pragma unroll
    for (int i = 0; i < NKL; ++i) {
      int id = tid + 256 * i;
      int kk = id / KCH, cc = id % KCH;
      kreg[i] = *(const u32x4*)(Kb + (size_t)key_tok(kt, kk) * kld + cc * 8);
    }
#pragma unroll
    for (int i = 0; i < 2; ++i) {
      int id = tid + 256 * i;
      int kk = id >> 3, cc = id & 7;
      vreg[i] = *(const u32x4*)(Vb + (size_t)key_tok(kt, kk) * vld + cc * 8);
    }
  };
  auto store_tile = [&]() {
#pragma unroll
    for (int i = 0; i < NKL; ++i) {
      int id = tid + 256 * i;
      int kk = id / KCH, cc = id % KCH;
      *(u32x4*)(Ks + kk * KSTR + cc * 8) = kreg[i];
    }
#pragma unroll
    for (int i = 0; i < 2; ++i) {
      int id = tid + 256 * i;
      int kk = id >> 3, cc = id & 7;
      *(u32x4*)(Vs + kk * VSTR + cc * 8) = vreg[i];
    }
  };

  f32x16 O[2];
#pragma unroll
  for (int i = 0; i < 16; ++i) { O[0][i] = 0.f; O[1][i] = 0.f; }
  float m = NEGBIG, lsum = 0.f;
  const int i16 = lane & 15, tq = i16 >> 2, tp = i16 & 3, tu = (lane >> 4) & 1;
  const u16* vtr = Vs + (4 * h + tq) * VSTR + 16 * tu + 4 * tp;

  load_tile(0);
  for (int kt = 0; kt < nkt; ++kt) {
    __syncthreads();
    store_tile();
    __syncthreads();
    if (kt + 1 < nkt) load_tile(kt + 1);

    bool use = true;
    int kmb = 0;
    if constexpr (MODE == 1) {
      kmb = qb * 128 - 64 + kt * 64;
      const int qw = qb * 128 + 32 * w;
      use = !(kmb > qw + 95 || kmb + 63 < qw - 64 || kmb + 63 < 0 || kmb >= L);
    } else if constexpr (MODE == 2) {
      const int krow = rsU + kt;
      use = (krow >= rsq) && (krow < rsq + 8);
    }
    if (use) {
      f32x16 sacc[2];
#pragma unroll
      for (int kg = 0; kg < 2; ++kg) {
#pragma unroll
        for (int i = 0; i < 16; ++i) sacc[kg][i] = 0.f;
#pragma unroll
        for (int ks = 0; ks < NKS; ++ks) {
          bf16x8 kf = *(const bf16x8*)(Ks + (32 * kg + r) * KSTR + 16 * ks + 8 * h);
          sacc[kg] = mfma(kf, qf[ks], sacc[kg]);
        }
      }
      if constexpr (MODE == 1) {
        const int qm = qb * 128 + 32 * w + r;
#pragma unroll
        for (int kg = 0; kg < 2; ++kg)
#pragma unroll
          for (int i = 0; i < 16; ++i) {
            const int km = kmb + 32 * kg + crow(i, h);
            const int df = km - qm;
            const bool ok = (km >= 0) && (km < L) && (df <= 64) && (df >= -64);
            sacc[kg][i] = ok ? sacc[kg][i] : NEGBIG;
          }
      } else if constexpr (MODE == 2) {
        const int krow = rsU + kt;
        const float* brow = bias + (krow - qr + 7) * 31;
#pragma unroll
        for (int kg = 0; kg < 2; ++kg)
#pragma unroll
          for (int i = 0; i < 16; ++i) {
            const int kc = 32 * kg + crow(i, h);
            const bool ok = (kc >= csq) && (kc < csq + 16);
            const int co = min(max(kc - qc + 15, 0), 30);
            sacc[kg][i] = ok ? sacc[kg][i] + brow[co] : NEGBIG;
          }
      }
      float mx = sacc[0][0];
#pragma unroll
      for (int kg = 0; kg < 2; ++kg)
#pragma unroll
        for (int i = 0; i < 16; ++i) mx = fmaxf(mx, sacc[kg][i]);
      mx = fmaxf(mx, __shfl_xor(mx, 32));
      const float mnew = fmaxf(m, mx);
      const float alpha = __builtin_amdgcn_exp2f(m - mnew);
      m = mnew;
      float ps = 0.f;
#pragma unroll
      for (int kg = 0; kg < 2; ++kg)
#pragma unroll
        for (int i = 0; i < 16; ++i) {
          float pv = __builtin_amdgcn_exp2f(sacc[kg][i] - mnew);
          sacc[kg][i] = pv;
          ps += pv;
        }
      lsum = lsum * alpha + ps;
#pragma unroll
      for (int i = 0; i < 16; ++i) { O[0][i] *= alpha; O[1][i] *= alpha; }
#pragma unroll
      for (int kg = 0; kg < 2; ++kg)
#pragma unroll
        for (int s2 = 0; s2 < 2; ++s2) {
          uint4 pk;
          pk.x = pack2(sacc[kg][8 * s2 + 0], sacc[kg][8 * s2 + 1]);
          pk.y = pack2(sacc[kg][8 * s2 + 2], sacc[kg][8 * s2 + 3]);
          pk.z = pack2(sacc[kg][8 * s2 + 4], sacc[kg][8 * s2 + 5]);
          pk.w = pack2(sacc[kg][8 * s2 + 6], sacc[kg][8 * s2 + 7]);
          const bf16x8 pf = __builtin_bit_cast(bf16x8, pk);
#pragma unroll
          for (int dt = 0; dt < 2; ++dt) {
            const u16* va = vtr + (32 * kg + 16 * s2) * VSTR + 32 * dt;
            s16x4 lo = __builtin_amdgcn_ds_read_tr16_b64_v4i16((LDSP s16x4*)(va));
            s16x4 hi = __builtin_amdgcn_ds_read_tr16_b64_v4i16((LDSP s16x4*)(va + 8 * VSTR));
            bf16x8 vf = __builtin_shufflevector(lo, hi, 0, 1, 2, 3, 4, 5, 6, 7);
            O[dt] = mfma(vf, pf, O[dt]);
          }
        }
    }
  }
  const float ltot = lsum + __shfl_xor(lsum, 32);
  const float inv = 1.f / ltot;
  if constexpr (MODE == 1) {
    u16* dst = p.ob + ((size_t)grp * CT + tlq) * 256 + hj * 64;
#pragma unroll
    for (int dt = 0; dt < 2; ++dt)
#pragma unroll
      for (int g = 0; g < 4; ++g)
        st4(dst + 32 * dt + 8 * g + 4 * h, O[dt][4 * g] * inv, O[dt][4 * g + 1] * inv, O[dt][4 * g + 2] * inv,
            O[dt][4 * g + 3] * inv);
    if (h == 0) p.lseb[((size_t)grp * CT + tlq) * 4 + hj] = m + __log2f(ltot);
  } else {
    u16* gp = (MODE == 0) ? p.ga + (size_t)tlq * 512 + hd * 64 : p.gc + (size_t)tlq * 512 + hd * 64;
#pragma unroll
    for (int dt = 0; dt < 2; ++dt)
#pragma unroll
      for (int g = 0; g < 4; ++g) {
        u16* a = gp + 32 * dt + 8 * g + 4 * h;
        uint2 gv = *(const uint2*)a;
        st4(a, O[dt][4 * g] * inv * bflo(gv.x), O[dt][4 * g + 1] * inv * bfhi(gv.x), O[dt][4 * g + 2] * inv * bflo(gv.y),
            O[dt][4 * g + 3] * inv * bfhi(gv.y));
      }
  }
}
DI void phase_attn(const Params& p, int l, int S, char* smem) {
  constexpr int N_MLA = (CT / 128) * 8;
  constexpr int N_NA = (CT / 128) * 8;
  constexpr int N_DIL = (CT / 128) * 12;
  for (int it = blockIdx.x; it < N_MLA + N_NA + N_DIL; it += gridDim.x) {
    if (it < N_MLA) attn_item<0>(p, it, l, S, smem);
    else if (it < N_MLA + N_NA) attn_item<2>(p, it - N_MLA, l, S, smem);
    else attn_item<1>(p, it - N_MLA - N_NA, l, S, smem);
  }
}

DI void phase_dilcomb(const Params& p) {
  const int tid_ = get_tid();
  for (int e = blockIdx.x * 256 + tid_; e < CT * 32; e += gridDim.x * 256) {
    const int tl = e >> 5, j = (e >> 3) & 3, ch = e & 7;
    float l0 = p.lseb[((size_t)0 * CT + tl) * 4 + j], l1 = p.lseb[((size_t)1 * CT + tl) * 4 + j],
          l2 = p.lseb[((size_t)2 * CT + tl) * 4 + j];
    float mx = fmaxf(l0, fmaxf(l1, l2));
    float w0 = __builtin_amdgcn_exp2f(l0 - mx), w1 = __builtin_amdgcn_exp2f(l1 - mx), w2 = __builtin_amdgcn_exp2f(l2 - mx);
    float iw = 1.f / (w0 + w1 + w2);
    w0 *= iw; w1 *= iw; w2 *= iw;
    const size_t off = (size_t)tl * 256 + j * 64 + ch * 8;
    uint4 a = *(const uint4*)(p.ob + off), b = *(const uint4*)(p.ob + (size_t)CT * 256 + off),
          c = *(const uint4*)(p.ob + (size_t)2 * CT * 256 + off);
    uint4 gv = *(const uint4*)(p.gb + off);
    uint4 o;
    o.x = pack2((w0 * bflo(a.x) + w1 * bflo(b.x) + w2 * bflo(c.x)) * bflo(gv.x),
                (w0 * bfhi(a.x) + w1 * bfhi(b.x) + w2 * bfhi(c.x)) * bfhi(gv.x));
    o.y = pack2((w0 * bflo(a.y) + w1 * bflo(b.y) + w2 * bflo(c.y)) * bflo(gv.y),
                (w0 * bfhi(a.y) + w1 * bfhi(b.y) + w2 * bfhi(c.y)) * bfhi(gv.y));
    o.z = pack2((w0 * bflo(a.z) + w1 * bflo(b.z) + w2 * bflo(c.z)) * bflo(gv.z),
                (w0 * bfhi(a.z) + w1 * bfhi(b.z) + w2 * bfhi(c.z)) * bfhi(gv.z));
    o.w = pack2((w0 * bflo(a.w) + w1 * bflo(b.w) + w2 * bflo(c.w)) * bflo(gv.w),
                (w0 * bfhi(a.w) + w1 * bfhi(b.w) + w2 * bfhi(c.w)) * bfhi(gv.w));
    *(uint4*)(p.gb + off) = o;
  }
}

DI void phase_branch(const Params& p, int l, char* smem) {
  u16* smW = (u16*)smem;
  u16* smA = smW + 128 * GSTR;
  const int tid = get_tid(), lane = tid & 63, wv = tid >> 6, wm = wv & 1, wn = wv >> 1, r = lane & 31, h = lane >> 5;
  constexpr int MT = CT / 64;
  for (int tile = blockIdx.x; tile < MT * 8; tile += gridDim.x) {
    const int n0 = (tile / MT) * 128, m0 = (tile % MT) * 64;
    const int tl = m0 + wm * 32 + r;
    f32x16 mix[2][1];
    zero_acc<1>(mix);
#pragma unroll 1
    for (int br = 0; br < 3; ++br) {
      const int K = (br == 1) ? 256 : 512;
      const u16* A = (br == 0) ? p.ga + (size_t)m0 * 512 : (br == 1) ? p.gb + (size_t)m0 * 256 : p.gc + (size_t)m0 * 512;
      const u16* W = (br == 0) ? p.wt_pa + (size_t)l * 1024 * 512 : (br == 1) ? p.wt_pb + (size_t)l * 1024 * 256
                                                                                 : p.wt_pc + (size_t)l * 1024 * 512;
      f32x16 acc[2][1];
      zero_acc<1>(acc);
      gemm_core<1>(acc, W + (size_t)n0 * K, K, A, K, K, smW, smA);
      const u16* mgp = p.mg + (size_t)tl * 3072 + br * 1024 + n0 + wn * 64;
#pragma unroll
      for (int nt = 0; nt < 2; ++nt)
#pragma unroll
        for (int g = 0; g < 4; ++g) {
          uint2 mv = *(const uint2*)(mgp + nt * 32 + 8 * g + 4 * h);
          mix[nt][0][4 * g] += bflo(mv.x) * acc[nt][0][4 * g];
          mix[nt][0][4 * g + 1] += bfhi(mv.x) * acc[nt][0][4 * g + 1];
          mix[nt][0][4 * g + 2] += bflo(mv.y) * acc[nt][0][4 * g + 2];
          mix[nt][0][4 * g + 3] += bfhi(mv.y) * acc[nt][0][4 * g + 3];
        }
    }
    u16* dst = p.mixed + (size_t)tl * 1024 + n0 + wn * 64;
#pragma unroll
    for (int nt = 0; nt < 2; ++nt)
#pragma unroll
      for (int g = 0; g < 4; ++g)
        st4(dst + nt * 32 + 8 * g + 4 * h, mix[nt][0][4 * g], mix[nt][0][4 * g + 1], mix[nt][0][4 * g + 2],
            mix[nt][0][4 * g + 3]);
  }
}

DI void phase_out(const Params& p, int l, char* smem) {
  u16* smW = (u16*)smem;
  u16* smA = smW + 128 * GSTR;
  const int tid = get_tid(), lane = tid & 63, wv = tid >> 6, wm = wv & 1, wn = wv >> 1, r = lane & 31, h = lane >> 5;
  constexpr int MT = CT / 128;
  for (int tile = blockIdx.x; tile < MT * 8; tile += gridDim.x) {
    const int n0 = (tile / MT) * 128, m0 = (tile % MT) * 128;
    f32x16 acc[2][2];
    zero_acc<2>(acc);
    gemm_core<2>(acc, p.wt_out + (size_t)l * 1024 * 1024 + (size_t)n0 * 1024, 1024, p.mixed + (size_t)m0 * 1024, 1024, 1024, smW,
              smA);
#pragma unroll
    for (int mt = 0; mt < 2; ++mt) {
      const int tl = m0 + wm * 64 + mt * 32 + r;
      float* dst = p.outb + (size_t)tl * 1024 + n0 + wn * 64;
#pragma unroll
      for (int nt = 0; nt < 2; ++nt)
#pragma unroll
        for (int g = 0; g < 4; ++g) {
          float4 v = {acc[nt][mt][4 * g], acc[nt][mt][4 * g + 1], acc[nt][mt][4 * g + 2], acc[nt][mt][4 * g + 3]};
          *(float4*)(dst + nt * 32 + 8 * g + 4 * h) = v;
        }
    }
  }
}

constexpr int SMEM_BYTES = 2 * 128 * GSTR * 2 + 512;
__global__ void __launch_bounds__(256, 2) mega_kernel(Params p) {
  cg::grid_group grid = cg::this_grid();
  __shared__ __attribute__((aligned(16))) char smem[SMEM_BYTES];
  phase_prep(p, smem);
  grid.sync();
#pragma unroll 1
  for (int c = 0; c < NCHUNK; ++c) {
    const int S = (c < 2) ? 2048 : 4096;
    const int bbase = (c < 2) ? c * 8 : 16 + (c - 2) * 4;
    phase_norm0(p, c, S, bbase);
    grid.sync();
#pragma unroll 1
    for (int l = 0; l < DEPTH; ++l) {
      phase_inproj(p, l, S, smem);
      grid.sync();
      phase_upproj(p, l, S, smem);
      grid.sync();
      phase_attn(p, l, S, smem);
      grid.sync();
      phase_dilcomb(p);
      grid.sync();
      phase_branch(p, l, smem);
      grid.sync();
      phase_out(p, l, smem);
      grid.sync();
      phase_post(p, c, l, S, bbase);
      grid.sync();
    }
  }
}

extern "C" void kernel_launch(void* const* d_in, const int* in_sizes, int n_in, void* d_out, int out_size, void* d_ws,
                              size_t ws_size, hipStream_t stream) {
  static int grid_blocks = 0;
  if (!grid_blocks) {
    int dev = 0, cus = 0, per_cu = 0;
    hipGetDevice(&dev);
    hipDeviceGetAttribute(&cus, hipDeviceAttributeMultiprocessorCount, dev);
    hipOccupancyMaxActiveBlocksPerMultiprocessor(&per_cu, mega_kernel, 256, 0);
    if (per_cu > 2) per_cu = 2;
    if (per_cu < 1) per_cu = 1;
    grid_blocks = cus * per_cu;
  }
  Params p;
  memset(&p, 0, sizeof(p));
  p.x_prompt = (const float*)d_in[0];  p.x_sample = (const float*)d_in[1];
  p.c_prompt = (const float*)d_in[2];  p.c_sample = (const float*)d_in[3];
  p.w_ada = (const float*)d_in[4];     p.b_ada = (const float*)d_in[5];
  p.g_pre = (const float*)d_in[6];     p.g_post = (const float*)d_in[7];
  p.w_in = (const float*)d_in[8];      p.g_q = (const float*)d_in[9];
  p.w_uq = (const float*)d_in[10];     p.g_kv = (const float*)d_in[11];
  p.w_ukv = (const float*)d_in[12];    p.rpb = (const float*)d_in[13];
  p.w_pa = (const float*)d_in[14];     p.w_pb = (const float*)d_in[15];
  p.w_pc = (const float*)d_in[16];     p.w_out = (const float*)d_in[17];
  p.out = (float*)d_out;
  char* ws = (char*)d_ws;
  size_t off = 0;
  auto take = [&](size_t bytes) { char* q = ws + off; off += (bytes + 255) & ~(size_t)255; return q; };
  p.wt_in = (u16*)take((size_t)DEPTH * NIN * DM * 2);
  p.wt_uq = (u16*)take((size_t)DEPTH * 768 * 384 * 2);
  p.wt_ukv = (u16*)take((size_t)DEPTH * 1024 * 256 * 2);
  p.wt_pa = (u16*)take((size_t)DEPTH * 1024 * 512 * 2);
  p.wt_pb = (u16*)take((size_t)DEPTH * 1024 * 256 * 2);
  p.wt_pc = (u16*)take((size_t)DEPTH * 1024 * 512 * 2);
  p.wt_out = (u16*)take((size_t)DEPTH * 1024 * 1024 * 2);
  p.mod = (float*)take((size_t)DEPTH * 24 * 3072 * 4);
  p.ropeB = (float2*)take((size_t)4096 * 32 * 8);
  p.ropeA = (float2*)take((size_t)4096 * 16 * 8);
  p.hbuf = (u16*)take((size_t)CT * 1024 * 2);
  p.qa = p.hbuf;
  p.qkvb = (u16*)take((size_t)CT * 2304 * 2);
  p.outb = (float*)p.qkvb;
  p.qkvc = (u16*)take((size_t)CT * 1536 * 2);
  p.mixed = p.qkvc;
  p.mg = (u16*)take((size_t)CT * 3072 * 2);
  p.ga = (u16*)take((size_t)CT * 512 * 2);
  p.gb = (u16*)take((size_t)CT * 256 * 2);
  p.gc = (u16*)take((size_t)CT * 512 * 2);
  p.cq = (u16*)take((size_t)CT * 384 * 2);
  p.ckv = (u16*)take((size_t)CT * 256 * 2);
  p.ka = (u16*)take((size_t)CT * 768 * 2);
  p.va = (u16*)take((size_t)CT * 512 * 2);
  p.ob = (u16*)take((size_t)3 * CT * 256 * 2);
  p.lseb = (float*)take((size_t)3 * CT * 4 * 4);
  if (off > ws_size) fprintf(stderr, "workspace too small: need %zu have %zu\n", off, ws_size);
  void* args[] = {&p};
  hipError_t e = hipLaunchCooperativeKernel((void*)mega_kernel, dim3(grid_blocks), dim3(256), args, 0, stream);
  if (e != hipSuccess) fprintf(stderr, "cooperative launch failed: %s (grid %d)\n", hipGetErrorString(e), grid_blocks);
}
```

```cpp
#include <hip/hip_runtime.h>
#include <hip/hip_cooperative_groups.h>
#include <stdint.h>
#include <string.h>
#include <stdio.h>
namespace cg = cooperative_groups;
#ifndef PROBE_REP
#define PROBE_REP 0
#endif

typedef unsigned short u16;
typedef short bf16x8 __attribute__((ext_vector_type(8)));
typedef short s16x4 __attribute__((ext_vector_type(4)));
typedef float f32x16 __attribute__((ext_vector_type(16)));
typedef uint32_t u32x4 __attribute__((ext_vector_type(4)));
typedef __bf16 bf2_t __attribute__((ext_vector_type(2)));
typedef float f2_t __attribute__((ext_vector_type(2)));
#define DI __device__ __forceinline__
#define LDSP __attribute__((address_space(3)))

constexpr int DM = 1024;
constexpr int DEPTH = 4;
constexpr int NPTOK = 32768;
constexpr int NTOK = 65536;
constexpr int CT = 16384;
constexpr int NCHUNK = NTOK / CT;
constexpr int NIN = 8960;
constexpr int D_IN = 8864;
constexpr float EPS = 1e-6f;
constexpr float LOG2E = 1.4426950408889634f;
constexpr float QS_A = 0.10206207261596577f * LOG2E;
constexpr float QS_64 = 0.125f * LOG2E;
constexpr float NEGBIG = -1e30f;

constexpr int SEC_QKVB = 0, SEC_QKVC = 2304, SEC_MG = 3840, SEC_GA = 6912, SEC_GB = 7424, SEC_GC = 7680,
              SEC_CQ = 8192, SEC_CKV = 8576, SEC_KR = 8832, SEC_PAD = 8896;

constexpr size_t al256(size_t x) { return (x + 255) & ~(size_t)255; }
constexpr size_t OFF_WT_IN = 0;
constexpr size_t OFF_WT_UQ = OFF_WT_IN + al256((size_t)DEPTH * NIN * DM * 2);
constexpr size_t OFF_WT_UKV = OFF_WT_UQ + al256((size_t)DEPTH * 768 * 384 * 2);
constexpr size_t OFF_WT_PA = OFF_WT_UKV + al256((size_t)DEPTH * 1024 * 256 * 2);
constexpr size_t OFF_WT_PB = OFF_WT_PA + al256((size_t)DEPTH * 1024 * 512 * 2);
constexpr size_t OFF_WT_PC = OFF_WT_PB + al256((size_t)DEPTH * 1024 * 256 * 2);
constexpr size_t OFF_WT_OUT = OFF_WT_PC + al256((size_t)DEPTH * 1024 * 512 * 2);
constexpr size_t OFF_MOD = OFF_WT_OUT + al256((size_t)DEPTH * 1024 * 1024 * 2);
constexpr size_t OFF_ROPEB = OFF_MOD + al256((size_t)DEPTH * 24 * 3072 * 4);
constexpr size_t OFF_ROPEA = OFF_ROPEB + al256((size_t)4096 * 32 * 8);
constexpr size_t OFF_HBUF = OFF_ROPEA + al256((size_t)4096 * 16 * 8);
constexpr size_t OFF_QKVB = OFF_HBUF + al256((size_t)CT * 1024 * 2);
constexpr size_t OFF_QKVC = OFF_QKVB + al256((size_t)CT * 2304 * 2);
constexpr size_t OFF_MG = OFF_QKVC + al256((size_t)CT * 1536 * 2);
constexpr size_t OFF_GA = OFF_MG + al256((size_t)CT * 3072 * 2);
constexpr size_t OFF_GB = OFF_GA + al256((size_t)CT * 512 * 2);
constexpr size_t OFF_GC = OFF_GB + al256((size_t)CT * 256 * 2);
constexpr size_t OFF_CQ = OFF_GC + al256((size_t)CT * 512 * 2);
constexpr size_t OFF_CKV = OFF_CQ + al256((size_t)CT * 384 * 2);
constexpr size_t OFF_KA = OFF_CKV + al256((size_t)CT * 256 * 2);
constexpr size_t OFF_VA = OFF_KA + al256((size_t)CT * 768 * 2);
constexpr size_t OFF_OB = OFF_VA + al256((size_t)CT * 512 * 2);
constexpr size_t OFF_LSEB = OFF_OB + al256((size_t)3 * CT * 256 * 2);
constexpr size_t OFF_RSQ = OFF_LSEB + al256((size_t)3 * CT * 4 * 4);
constexpr size_t OFF_RSKV = OFF_RSQ + al256((size_t)CT * 12 * 4);
constexpr size_t OFF_BAR = OFF_RSKV + al256((size_t)CT * 8 * 4);
constexpr size_t BAR_BYTES = 3456 * 4;
constexpr size_t WS_NEEDED = OFF_BAR + al256(BAR_BYTES);

DI int tid_from_wave(int wv);
struct Params {
  const float *x_prompt, *x_sample, *c_prompt, *c_sample, *w_ada, *b_ada, *g_pre, *g_post, *w_in, *g_q, *w_uq, *g_kv,
      *w_ukv, *rpb, *w_pa, *w_pb, *w_pc, *w_out;
  float* out;
  char* ws;
  int wv, pad_;
  DI u16* wt_in() const { return (u16*)(ws + OFF_WT_IN); }
  DI u16* wt_uq() const { return (u16*)(ws + OFF_WT_UQ); }
  DI u16* wt_ukv() const { return (u16*)(ws + OFF_WT_UKV); }
  DI u16* wt_pa() const { return (u16*)(ws + OFF_WT_PA); }
  DI u16* wt_pb() const { return (u16*)(ws + OFF_WT_PB); }
  DI u16* wt_pc() const { return (u16*)(ws + OFF_WT_PC); }
  DI u16* wt_out() const { return (u16*)(ws + OFF_WT_OUT); }
  DI float* mod() const { return (float*)(ws + OFF_MOD); }
  DI float2* ropeB() const { return (float2*)(ws + OFF_ROPEB); }
  DI float2* ropeA() const { return (float2*)(ws + OFF_ROPEA); }
  DI u16* hbuf() const { return (u16*)(ws + OFF_HBUF); }
  DI u16* qa() const { return (u16*)(ws + OFF_HBUF); }
  DI u16* qkvb() const { return (u16*)(ws + OFF_QKVB); }
  DI u16* outh() const { return (u16*)(ws + OFF_QKVB); }
  DI u16* qkvc() const { return (u16*)(ws + OFF_QKVC); }
  DI u16* mixed() const { return (u16*)(ws + OFF_QKVC); }
  DI u16* mg() const { return (u16*)(ws + OFF_MG); }
  DI u16* ga() const { return (u16*)(ws + OFF_GA); }
  DI u16* gb() const { return (u16*)(ws + OFF_GB); }
  DI u16* gc() const { return (u16*)(ws + OFF_GC); }
  DI u16* cq() const { return (u16*)(ws + OFF_CQ); }
  DI u16* ckv() const { return (u16*)(ws + OFF_CKV); }
  DI u16* ka() const { return (u16*)(ws + OFF_KA); }
  DI u16* va() const { return (u16*)(ws + OFF_VA); }
  DI u16* ob() const { return (u16*)(ws + OFF_OB); }
  DI float* lseb() const { return (float*)(ws + OFF_LSEB); }
  DI float* rowss_q() const { return (float*)(ws + OFF_RSQ); }
  DI float* rowss_kv() const { return (float*)(ws + OFF_RSKV); }
};

DI int get_tid(const Params& p) { return tid_from_wave(p.wv); }

DI uint32_t pack2(float a, float b) {
  f2_t v = {a, b};
  bf2_t r = __builtin_convertvector(v, bf2_t);
  return __builtin_bit_cast(uint32_t, r);
}
DI float bflo(uint32_t u) { return __uint_as_float(u << 16); }
DI float bfhi(uint32_t u) { return __uint_as_float(u & 0xffff0000u); }
DI void st4(u16* dst, float a, float b, float c, float d) {
  uint2 v;
  v.x = pack2(a, b);
  v.y = pack2(c, d);
  *(uint2*)dst = v;
}
DI float sigmoidf_(float x) { return 1.f / (1.f + __expf(-x)); }
DI float siluf_(float x) { return x / (1.f + __expf(-x)); }
DI int tid_from_wave(int wv) {
  int lane;
  asm volatile("v_mbcnt_lo_u32_b32 %0, -1, 0\n\tv_mbcnt_hi_u32_b32 %0, -1, %0" : "=v"(lane));
  return (wv << 6) | lane;
}
DI int crow(int reg, int h) { return (reg & 3) + 8 * (reg >> 2) + 4 * h; }
DI f32x16 mfma(bf16x8 a, bf16x8 b, f32x16 c) { return __builtin_amdgcn_mfma_f32_32x32x16_bf16(a, b, c, 0, 0, 0); }
template <int K>
DI float swz_xor(float v) { return __int_as_float(__builtin_amdgcn_ds_swizzle(__float_as_int(v), (K << 10) | 0x1f)); }
DI float half_add(float v) {
  auto r = __builtin_amdgcn_permlane32_swap(__float_as_uint(v), __float_as_uint(v), false, false);
  return __uint_as_float(r[0]) + __uint_as_float(r[1]);
}
DI float half_max(float v) {
  auto r = __builtin_amdgcn_permlane32_swap(__float_as_uint(v), __float_as_uint(v), false, false);
  return fmaxf(__uint_as_float(r[0]), __uint_as_float(r[1]));
}
DI float wave_sum(float v) {
  v += swz_xor<1>(v); v += swz_xor<2>(v); v += swz_xor<4>(v); v += swz_xor<8>(v); v += swz_xor<16>(v);
  return half_add(v);
}

namespace pg8 {
#define PG8_LAS __attribute__((address_space(3)))
typedef unsigned short bf16_t;
typedef short bf16x8 __attribute__((ext_vector_type(8)));
typedef float f32x4 __attribute__((ext_vector_type(4)));
typedef unsigned u32x4 __attribute__((ext_vector_type(4)));
constexpr int BM = 256, BK = 64, HALF = 128, HTB = HALF * BK * 2  , STAGE_BYTES = 8 * HTB, NXCD = 8, WGM = 8;

__host__ __device__ __forceinline__ int lds_byte(int r, int c) { const int st = (r >> 4) * 2 + (c >> 5), rr = r & 15, cc = c & 31, ob = rr * 64 + cc * 2; return st * 1024 + (ob ^ (((ob >> 9) & 1) << 5)); }
__host__ __device__ __forceinline__ void stage_rc(int b, int& R, int& C) { const int st = b / 1024, sb = b % 1024, swz = sb ^ (((sb >> 9) & 1) << 5); R = (st >> 1) * 16 + swz / 64; C = (st & 1) * 32 + (swz % 64) / 2; }
__host__ __device__ __forceinline__ int perm32(int rho) { const int n = rho >> 4, i = rho & 15; return 8 * (i >> 2) + 4 * n + (i & 3); }

struct Unit { int pm, pn; };
struct Gemm { const bf16_t* A; const bf16_t* Bt; int M, N, K; };

struct StaticOrder {
    int nM, nN, nwg, G, c;
    __host__ __device__ void init(int M, int N, int G_, int c_) { nM = M / BM; nN = N / BM; nwg = nM * nN; G = G_; c = c_; }
    __host__ __device__ bool next(int i, Unit& u) const {
        const long L = (long)i * G + c; if (L >= nwg) return false;
        int wgid = (int)L; { const int q = nwg / NXCD, r = nwg % NXCD, xcd = wgid % NXCD, off = wgid / NXCD; wgid = (xcd < r ? xcd * (q + 1) : r * (q + 1) + (xcd - r) * q) + off; }
        const int nig = WGM * nN, gid = wgid / nig, fm = gid * WGM, gsz = (nM - fm) < WGM ? (nM - fm) : WGM;
        u.pm = fm + ((wgid % nig) % gsz); u.pn = (wgid % nig) / gsz; return true;
    }
    __device__ __forceinline__ void a_ready(const Unit&) const {}
    __device__ __forceinline__ void done(const Unit&) const {}
};

template <class Epi, class Sched, bool STAMP = false>
__device__ __forceinline__ void gemm_phase(PG8_LAS unsigned char* lds, const Gemm g, const Sched& S, const Epi& E, unsigned long long* stamps) {
    const int tid = get_tid(E.p), wid = __builtin_amdgcn_readfirstlane(tid >> 6), lane = tid & 63, wr = wid >> 2, wc = wid & 3, fr = lane & 15, fq = lane >> 4;
    const int K = g.K, nt = K / BK;
    int ts_lo = 0, ts_hi = 0, nts = 0; const unsigned long long rt_entry = STAMP ? (unsigned long long)wall_clock64() : 0ull;
#define PG8_STAMP() do { if (STAMP && wid == 0 && nts < 64) { const unsigned long long _c = (unsigned long long)clock64(); \
        ts_lo = (lane == nts) ? (int)(unsigned)_c : ts_lo; ts_hi = (lane == nts) ? (int)(unsigned)(_c >> 32) : ts_hi; ++nts; } } while (0)
    PG8_STAMP();
    unsigned voffA[2], voffB[2];
#pragma unroll
    for (int i = 0; i < 2; ++i) { int R, C; stage_rc(tid * 16 + i * 8192, R, C); const int Rb = Epi::PERM ? ((R & ~31) + perm32(R & 31)) : R;
        voffA[i] = (unsigned)(R * K + C) * 2u; voffB[i] = (unsigned)(Rb * K + C) * 2u; }
    const size_t kstep = (size_t)(BK * 2);
    const size_t hstep = (size_t)HALF * K * 2;
    const size_t tstep = 2 * hstep;
    const unsigned ldsw = (unsigned)wid * 1024u;
    const int aoff = lds_byte(wr * 64 + fr, fq * 8), boff = lds_byte(wc * 32 + fr, fq * 8);
#define PG8_SA(b, h) (((b) * 2 + (h)) * HTB)
#define PG8_SB(b, h) ((4 + (b) * 2 + (h)) * HTB)
#define PG8_STAGE(bufoff, gbase, voff) do { _Pragma("unroll") for (int _i = 0; _i < 2; ++_i) \
        __builtin_amdgcn_global_load_lds((const unsigned*)((const char*)(gbase) + (voff)[_i]), (PG8_LAS unsigned*)(lds + (bufoff) + ldsw + _i * 8192), 16, 0, 0); } while (0)
#define PG8_LDA(dst, b, h) do { _Pragma("unroll") for (int m = 0; m < 4; ++m) _Pragma("unroll") for (int k = 0; k < 2; ++k) dst[m][k] = *(const PG8_LAS bf16x8*)(lds + PG8_SA(b, h) + aoff + m * 2048 + k * 1024); } while (0)
#define PG8_LDB(dst, b, h) do { _Pragma("unroll") for (int n = 0; n < 2; ++n) _Pragma("unroll") for (int k = 0; k < 2; ++k) dst[n][k] = *(const PG8_LAS bf16x8*)(lds + PG8_SB(b, h) + boff + n * 2048 + k * 1024); } while (0)
#define PG8_MMA(ai, bj, At, Bt) do { __builtin_amdgcn_s_setprio(1); _Pragma("unroll") for (int m = 0; m < 4; ++m) _Pragma("unroll") for (int n = 0; n < 2; ++n) _Pragma("unroll") for (int k = 0; k < 2; ++k) \
        acc[ai][bj][m][n] = __builtin_amdgcn_mfma_f32_16x16x32_bf16(Bt[n][k], At[m][k], acc[ai][bj][m][n], 0, 0, 0); __builtin_amdgcn_s_setprio(0); } while (0)
#define PG8_WAIT_V(n) asm volatile("s_waitcnt vmcnt(" #n ")" ::: "memory")
#define PG8_WAIT_L(n) asm volatile("s_waitcnt lgkmcnt(" #n ")" ::: "memory")
#define PG8_BAR __builtin_amdgcn_s_barrier()
#define PG8_SCHED __builtin_amdgcn_sched_barrier(0)
    Unit cur, nxt; int ui = 0;
    if (!S.next(0, cur)) return;
    f32x4 acc[2][2][4][2];
#pragma unroll
    for (int a = 0; a < 2; ++a)
#pragma unroll
        for (int b = 0; b < 2; ++b)
#pragma unroll
            for (int m = 0; m < 4; ++m)
#pragma unroll
                for (int n = 0; n < 2; ++n) acc[a][b][m][n] = (f32x4){0.f, 0.f, 0.f, 0.f};
    bf16x8 At[4][2], B0[2][2], B1[2][2];
    const char* cA = (const char*)g.A + (size_t)cur.pm * tstep; const char* cB = (const char*)g.Bt + (size_t)cur.pn * tstep;
    S.a_ready(cur);
    PG8_STAGE(PG8_SB(0, 0), cB, voffB); PG8_STAGE(PG8_SA(0, 0), cA, voffA); PG8_STAGE(PG8_SB(0, 1), cB + hstep, voffB); PG8_STAGE(PG8_SA(0, 1), cA + hstep, voffA);
    if (wr == 1) PG8_BAR;
    PG8_WAIT_V(4); PG8_BAR;
    PG8_STAGE(PG8_SB(1, 0), cB + kstep, voffB); PG8_STAGE(PG8_SA(1, 0), cA + kstep, voffA); PG8_STAGE(PG8_SB(1, 1), cB + hstep + kstep, voffB);
    PG8_WAIT_V(6); PG8_BAR;
    PG8_STAMP();
    for (;;) {
        const bool has_next = S.next(ui + 1, nxt);
        const char* nA = has_next ? (const char*)g.A + (size_t)nxt.pm * tstep : cA; const char* nB = has_next ? (const char*)g.Bt + (size_t)nxt.pn * tstep : cB;
        for (int t = 0; t < nt; t += 2) {
            const bool last = (t == nt - 2);
            const char* a1 = cA + (size_t)(t + 1) * kstep;
            const char* a2 = last ? nA : cA + (size_t)(t + 2) * kstep; const char* b2 = last ? nB : cB + (size_t)(t + 2) * kstep;
            const char* a3 = a2 + kstep; const char* b3 = b2 + kstep;
            if (last && has_next) S.a_ready(nxt);
            PG8_LDB(B0, 0, 0); PG8_SCHED; PG8_LDA(At, 0, 0); PG8_STAGE(PG8_SA(1, 1), a1 + hstep, voffA);
            PG8_WAIT_L(8); PG8_BAR; PG8_WAIT_L(0); PG8_MMA(0, 0, At, B0); PG8_BAR; PG8_SCHED;
            PG8_LDB(B1, 0, 1); PG8_STAGE(PG8_SB(0, 0), b2, voffB);
            PG8_BAR; PG8_WAIT_L(0); PG8_MMA(0, 1, At, B1); PG8_BAR;
            PG8_LDA(At, 0, 1); PG8_STAGE(PG8_SA(0, 0), a2, voffA);
            PG8_BAR; PG8_WAIT_L(0); PG8_MMA(1, 0, At, B0); PG8_BAR; PG8_SCHED;
            PG8_STAGE(PG8_SB(0, 1), b2 + hstep, voffB);
            PG8_WAIT_V(6); PG8_BAR; PG8_MMA(1, 1, At, B1); PG8_BAR;
            PG8_LDB(B0, 1, 0); PG8_SCHED; PG8_LDA(At, 1, 0); PG8_STAGE(PG8_SA(0, 1), a2 + hstep, voffA);
            PG8_WAIT_L(8); PG8_BAR; PG8_WAIT_L(0); PG8_MMA(0, 0, At, B0); PG8_BAR; PG8_SCHED;
            PG8_LDB(B1, 1, 1); PG8_STAGE(PG8_SB(1, 0), b3, voffB);
            PG8_BAR; PG8_WAIT_L(0); PG8_MMA(0, 1, At, B1); PG8_BAR;
            PG8_LDA(At, 1, 1); PG8_STAGE(PG8_SA(1, 0), a3, voffA);
            PG8_BAR; PG8_WAIT_L(0); PG8_MMA(1, 0, At, B0); PG8_BAR; PG8_SCHED;
            PG8_STAGE(PG8_SB(1, 1), b3 + hstep, voffB);
            PG8_WAIT_V(6); PG8_BAR; PG8_MMA(1, 1, At, B1); PG8_BAR;
        }
        PG8_STAMP();
        if constexpr (!Epi::AFTER_DRAIN) { E(acc, cur, wr, wc, fr, fq); S.done(cur); }
        PG8_STAMP();
        if (!has_next) break;
#pragma unroll
        for (int a = 0; a < 2; ++a)
#pragma unroll
            for (int b = 0; b < 2; ++b)
#pragma unroll
                for (int m = 0; m < 4; ++m)
#pragma unroll
                    for (int n = 0; n < 2; ++n) acc[a][b][m][n] = (f32x4){0.f, 0.f, 0.f, 0.f};
        cur = nxt; cA = nA; cB = nB; ++ui;
    }
    PG8_WAIT_V(0);
    if (wr == 0) PG8_BAR;
    PG8_BAR;
    if constexpr (Epi::AFTER_DRAIN) { E.fused(acc, cur, wr, wc, fr, fq, lds, wid, lane); S.done(cur); }
    PG8_STAMP();
    if (STAMP && wid == 0) { stamps[lane] = lane < nts ? (((unsigned long long)(unsigned)ts_hi << 32) | (unsigned)ts_lo) : 0ull;
        if (lane == 62) stamps[62] = rt_entry; if (lane == 63) stamps[63] = (unsigned long long)wall_clock64(); }
#undef PG8_STAMP
#undef PG8_SA
#undef PG8_SB
#undef PG8_STAGE
#undef PG8_LDA
#undef PG8_LDB
#undef PG8_MMA
#undef PG8_WAIT_V
#undef PG8_WAIT_L
#undef PG8_BAR
#undef PG8_SCHED
}
}


DI void st4v(u16* dst, const pg8::f32x4& v) { st4(dst, v[0], v[1], v[2], v[3]); }

DI void st8(u16* dst, const pg8::f32x4& a, const pg8::f32x4& b) {
  uint4 v;
  v.x = pack2(a[0], a[1]); v.y = pack2(a[2], a[3]); v.z = pack2(b[0], b[1]); v.w = pack2(b[2], b[3]);
  *(uint4*)dst = v;
}
DI float fsig(float x) { return __builtin_amdgcn_rcpf(1.f + __builtin_amdgcn_exp2f(-LOG2E * x)); }
DI pg8::f32x4 sig4(const pg8::f32x4& a) { return (pg8::f32x4){fsig(a[0]), fsig(a[1]), fsig(a[2]), fsig(a[3])}; }
DI pg8::f32x4 silu4(const pg8::f32x4& a) { return (pg8::f32x4){a[0] * fsig(a[0]), a[1] * fsig(a[1]), a[2] * fsig(a[2]), a[3] * fsig(a[3])}; }
DI pg8::f32x4 rope_lo(const pg8::f32x4& x1, const pg8::f32x4& x2, const float4& t0, const float4& t1) {
  return (pg8::f32x4){x1[0] * t0.x - x2[0] * t0.y, x1[1] * t0.z - x2[1] * t0.w, x1[2] * t1.x - x2[2] * t1.y, x1[3] * t1.z - x2[3] * t1.w};
}
DI pg8::f32x4 rope_hi(const pg8::f32x4& x1, const pg8::f32x4& x2, const float4& t0, const float4& t1) {
  return (pg8::f32x4){x2[0] * t0.x + x1[0] * t0.y, x2[1] * t0.z + x1[1] * t0.w, x2[2] * t1.x + x1[2] * t1.y, x2[3] * t1.z + x1[3] * t1.w};
}
DI pg8::f32x4 swap_lo(const pg8::f32x4& v) {
  pg8::f32x4 o;
#pragma unroll
  for (int k = 0; k < 4; ++k) { auto r = __builtin_amdgcn_permlane32_swap(__float_as_uint(v[k]), __float_as_uint(v[k]), false, false); o[k] = __uint_as_float(r[0]); }
  return o;
}
DI pg8::f32x4 swap_hi(const pg8::f32x4& v) {
  pg8::f32x4 o;
#pragma unroll
  for (int k = 0; k < 4; ++k) { auto r = __builtin_amdgcn_permlane32_swap(__float_as_uint(v[k]), __float_as_uint(v[k]), false, false); o[k] = __uint_as_float(r[1]); }
  return o;
}

struct EpiInproj {
  static constexpr bool PERM = true, AFTER_DRAIN = false;
  Params p; int S; bool atom;
  DI void operator()(const pg8::f32x4 (&acc)[2][2][4][2], const pg8::Unit& u, int wr, int wc, int fr_, int fq_) const {
    int fr = fr_, fq = fq_;
    asm volatile("" : "+v"(fr), "+v"(fq));
#pragma unroll
    for (int ai = 0; ai < 2; ++ai)
#pragma unroll
      for (int m = 0; m < 4; ++m) {
        const int tl = u.pm * 256 + ai * 128 + wr * 64 + m * 16 + fr;
        const int pos = tl & (S - 1);
        if (u.pn < 9) {
          const int which = u.pn / 3, head = (u.pn % 3) * 4 + wc;
          u16* dst = p.qkvb() + (size_t)tl * 2304 + which * 768 + head * 64 + 8 * fq;
          const pg8::f32x4 x1a = acc[ai][0][m][0], x1b = acc[ai][0][m][1], x2a = acc[ai][1][m][0], x2b = acc[ai][1][m][1];
          if (which < 2) {
            const float sc = (which == 0) ? QS_64 : 1.f;
            const float4* tab = (const float4*)(p.ropeB() + (size_t)pos * 32) + 4 * fq;
            const float4 t0 = tab[0], t1 = tab[1], t2 = tab[2], t3 = tab[3];
            st8(dst, rope_lo(x1a, x2a, t0, t1) * sc, rope_lo(x1b, x2b, t2, t3) * sc);
            st8(dst + 32, rope_hi(x1a, x2a, t0, t1) * sc, rope_hi(x1b, x2b, t2, t3) * sc);
          } else {
            st8(dst, x1a, x1b);
            st8(dst + 32, x2a, x2b);
          }
        } else {
#pragma unroll
          for (int bj = 0; bj < 2; ++bj) {
            const int c32 = u.pn * 256 + bj * 128 + wc * 32;
            const pg8::f32x4 a0 = acc[ai][bj][m][0], a1 = acc[ai][bj][m][1];
            if (c32 < SEC_MG) {
              const int i0 = c32 - SEC_QKVC;
              const float sc = (i0 < 512) ? QS_64 : 1.f;
              st8(p.qkvc() + (size_t)tl * 1536 + i0 + 8 * fq, a0 * sc, a1 * sc);
            } else if (c32 < SEC_GA) {
              st8(p.mg() + (size_t)tl * 3072 + (c32 - SEC_MG) + 8 * fq, sig4(a0), sig4(a1));
            } else if (c32 < SEC_CQ) {
              u16* dst;
              if (c32 < SEC_GB) dst = p.ga() + (size_t)tl * 512 + (c32 - SEC_GA);
              else if (c32 < SEC_GC) dst = p.gb() + (size_t)tl * 256 + (c32 - SEC_GB);
              else dst = p.gc() + (size_t)tl * 512 + (c32 - SEC_GC);
              st8(dst + 8 * fq, silu4(a0), silu4(a1));
            } else if (c32 < SEC_KR) {
              const bool isq = c32 < SEC_CKV;
              u16* dst = isq ? p.cq() + (size_t)tl * 384 + (c32 - SEC_CQ) : p.ckv() + (size_t)tl * 256 + (c32 - SEC_CKV);
              st8(dst + 8 * fq, a0, a1);
              float ss = a0[0] * a0[0] + a0[1] * a0[1] + a0[2] * a0[2] + a0[3] * a0[3] + a1[0] * a1[0] + a1[1] * a1[1] +
                         a1[2] * a1[2] + a1[3] * a1[3];
              ss += swz_xor<16>(ss);
              ss = half_add(ss);
              if (fq == 0 && atom) {
                if (isq) p.rowss_q()[(size_t)tl * 12 + ((c32 - SEC_CQ) >> 5)] = ss;
                else p.rowss_kv()[(size_t)tl * 8 + ((c32 - SEC_CKV) >> 5)] = ss;
              }
            } else if (c32 == SEC_KR) {
              const pg8::f32x4 x1a = swap_lo(a0), x1b = swap_lo(a1), x2a = swap_hi(a0), x2b = swap_hi(a1);
              const float4* tab = (const float4*)(p.ropeA() + (size_t)pos * 16) + 4 * (fq & 1);
              const float4 t0 = tab[0], t1 = tab[1], t2 = tab[2], t3 = tab[3];
              const bool lo = fq < 2;
              const pg8::f32x4 ya = lo ? rope_lo(x1a, x2a, t0, t1) : rope_hi(x1a, x2a, t0, t1);
              const pg8::f32x4 yb = lo ? rope_lo(x1b, x2b, t2, t3) : rope_hi(x1b, x2b, t2, t3);
              u16* dst = p.ka() + (size_t)tl * 768 + 64 + 8 * fq;
#pragma unroll
              for (int hd = 0; hd < 8; ++hd) st8(dst + hd * 96, ya, yb);
            }
          }
        }
      }
  }
};

template <bool ISQ>
struct EpiUp {
  static constexpr bool PERM = !ISQ, AFTER_DRAIN = false;
  Params p; int S;
  DI void operator()(const pg8::f32x4 (&acc)[2][2][4][2], const pg8::Unit& u, int wr, int wc, int fr_, int fq_) const {
    int fr = fr_, fq = fq_;
    asm volatile("" : "+v"(fr), "+v"(fq));
#pragma unroll
    for (int ai = 0; ai < 2; ++ai)
#pragma unroll
      for (int m = 0; m < 4; ++m) {
        const int tl = u.pm * 256 + ai * 128 + wr * 64 + m * 16 + fr;
        if (ISQ) {
          const float4* rq = (const float4*)(p.rowss_q() + (size_t)tl * 12);
          const float4 r0 = rq[0], r1 = rq[1], r2 = rq[2];
          const float ssq = ((((((((((r0.x + r0.y) + r0.z) + r0.w) + r1.x) + r1.y) + r1.z) + r1.w) + r2.x) + r2.y) + r2.z) + r2.w;
          const float sc = rsqrtf(ssq * (1.f / 384.f) + EPS) * QS_A;
          const int pos = tl & (S - 1);
#pragma unroll
          for (int bj = 0; bj < 2; ++bj) {
            const int c32 = u.pn * 256 + bj * 128 + wc * 32;
            const pg8::f32x4 a0 = acc[ai][bj][m][0], a1 = acc[ai][bj][m][1];
            u16* dst = p.qa() + (size_t)tl * 768 + c32 + 4 * fq;
            if ((c32 % 96) == 64) {
              const float4* tab = (const float4*)(p.ropeA() + (size_t)pos * 16);
              const float4 t0 = tab[2 * fq], t1 = tab[2 * fq + 1];
              st4(dst, (a0[0] * t0.x - a1[0] * t0.y) * sc, (a0[1] * t0.z - a1[1] * t0.w) * sc, (a0[2] * t1.x - a1[2] * t1.y) * sc,
                  (a0[3] * t1.z - a1[3] * t1.w) * sc);
              st4(dst + 16, (a1[0] * t0.x + a0[0] * t0.y) * sc, (a1[1] * t0.z + a0[1] * t0.w) * sc,
                  (a1[2] * t1.x + a0[2] * t1.y) * sc, (a1[3] * t1.z + a0[3] * t1.w) * sc);
            } else {
              st4v(dst, a0 * sc); st4v(dst + 16, a1 * sc);
            }
          }
        } else {
          const float4* rk = (const float4*)(p.rowss_kv() + (size_t)tl * 8);
          const float4 r0 = rk[0], r1 = rk[1];
          const float ssk = ((((((r0.x + r0.y) + r0.z) + r0.w) + r1.x) + r1.y) + r1.z) + r1.w;
          const float ri = rsqrtf(ssk * (1.f / 256.f) + EPS);
#pragma unroll
          for (int bj = 0; bj < 2; ++bj) {
            const int c32 = u.pn * 256 + bj * 128 + wc * 32;
            const int hd = c32 >> 7, e0 = c32 & 127;
            u16* dst = ((e0 < 64) ? p.ka() + (size_t)tl * 768 + hd * 96 + e0 : p.va() + (size_t)tl * 512 + hd * 64 + (e0 - 64)) + 8 * fq;
            st8(dst, acc[ai][bj][m][0] * ri, acc[ai][bj][m][1] * ri);
          }
        }
      }
  }
};

template <int BR>
struct EpiBranch {
  static constexpr bool PERM = true, AFTER_DRAIN = false;
  Params p;
  DI void operator()(const pg8::f32x4 (&acc)[2][2][4][2], const pg8::Unit& u, int wr, int wc, int fr_, int fq_) const {
    int fr = fr_, fq = fq_;
    asm volatile("" : "+v"(fr), "+v"(fq));
#pragma unroll
    for (int ai = 0; ai < 2; ++ai)
#pragma unroll
      for (int m = 0; m < 4; ++m) {
        const int tl = u.pm * 256 + ai * 128 + wr * 64 + m * 16 + fr;
#pragma unroll
        for (int bj = 0; bj < 2; ++bj) {
          const int c = u.pn * 256 + bj * 128 + wc * 32 + 8 * fq;
          const uint4 mv = *(const uint4*)(p.mg() + (size_t)tl * 3072 + BR * 1024 + c);
          pg8::f32x4 v0 = acc[ai][bj][m][0], v1 = acc[ai][bj][m][1];
          v0[0] *= bflo(mv.x); v0[1] *= bfhi(mv.x); v0[2] *= bflo(mv.y); v0[3] *= bfhi(mv.y);
          v1[0] *= bflo(mv.z); v1[1] *= bfhi(mv.z); v1[2] *= bflo(mv.w); v1[3] *= bfhi(mv.w);
          u16* mx = p.mixed() + (size_t)tl * 1024 + c;
          if (BR != 0) {
            const uint4 o = *(const uint4*)mx;
            v0[0] += bflo(o.x); v0[1] += bfhi(o.x); v0[2] += bflo(o.y); v0[3] += bfhi(o.y);
            v1[0] += bflo(o.z); v1[1] += bfhi(o.z); v1[2] += bflo(o.w); v1[3] += bfhi(o.w);
          }
          st8(mx, v0, v1);
        }
      }
  }
};

struct EpiOut {
  static constexpr bool PERM = true, AFTER_DRAIN = false;
  Params p;
  DI void operator()(const pg8::f32x4 (&acc)[2][2][4][2], const pg8::Unit& u, int wr, int wc, int fr_, int fq_) const {
    int fr = fr_, fq = fq_;
    asm volatile("" : "+v"(fr), "+v"(fq));
#pragma unroll
    for (int ai = 0; ai < 2; ++ai)
#pragma unroll
      for (int m = 0; m < 4; ++m) {
        const int tl = u.pm * 256 + ai * 128 + wr * 64 + m * 16 + fr;
#pragma unroll
        for (int bj = 0; bj < 2; ++bj)
          st8(p.outh() + (size_t)tl * 1024 + u.pn * 256 + bj * 128 + wc * 32 + 8 * fq, acc[ai][bj][m][0], acc[ai][bj][m][1]);
      }
  }
};

template <int NM, int NN>
struct FixedOrder {
  int G, c;
  DI bool next(int i, pg8::Unit& u) const {
    constexpr int nwg = NM * NN, q = nwg / 8, r = nwg % 8, nig = 8 * NN;
    const int L = i * G + c;
    if (L >= nwg) return false;
    const int xcd = L & 7, off = L >> 3;
    const int wgid = (xcd < r ? xcd * (q + 1) : r * (q + 1) + (xcd - r) * q) + off;
    const int gid = wgid / nig, rem = wgid % nig;
    u.pm = gid * 8 + (rem & 7);
    u.pn = rem >> 3;
    return true;
  }
  DI void a_ready(const pg8::Unit&) const {}
  DI void done(const pg8::Unit&) const {}
};

template <int N, int K, class Epi>
DI void run_gemm(char* smem, const u16* A, const u16* Bt, const Epi& E) {
  pg8::Gemm g{A, Bt, CT, N, K};
  FixedOrder<CT / 256, N / 256> so{(int)gridDim.x, (int)blockIdx.x};
  pg8::gemm_phase<Epi, FixedOrder<CT / 256, N / 256>, false>((PG8_LAS unsigned char*)smem, g, so, E, nullptr);
}

DI int inproj_orig_col(int np) {
  if (np < SEC_QKVC) {
    const int t = np >> 8, cc = np & 255, half = cc >> 7, hit = (cc >> 5) & 3;
    return 1184 + (t / 3) * 768 + ((t % 3) * 4 + hit) * 64 + half * 32;
  }
  if (np < SEC_MG) return 3744 + (np - SEC_QKVC);
  if (np < SEC_GA) return 5792 + (np - SEC_MG);
  if (np < SEC_GB) return 672 + (np - SEC_GA);
  if (np < SEC_GC) return 3488 + (np - SEC_GB);
  if (np < SEC_CQ) return 5280 + (np - SEC_GC);
  if (np < SEC_CKV) return 0 + (np - SEC_CQ);
  if (np < SEC_KR) return 384 + (np - SEC_CKV);
  if (np < SEC_KR + 32) return 640 + (np - SEC_KR);
  return -1;
}
DI void conv_tile(const float* __restrict__ src, int N, int ncol0, int k0, const float* __restrict__ kscale,
                  u16* __restrict__ dst, int K, int nrow0, float* tl, int tid) {
  __syncthreads();
  {
    const int kr = tid >> 3, n4 = (tid & 7) * 4;
#pragma unroll
    for (int i = 0; i < 2; ++i) {
      const int k = kr + 64 * i;
      float4 v = make_float4(0.f, 0.f, 0.f, 0.f);
      if (ncol0 >= 0) {
        v = *(const float4*)(src + (size_t)(k0 + k) * N + ncol0 + n4);
        if (kscale) { const float g = kscale[k0 + k]; v.x *= g; v.y *= g; v.z *= g; v.w *= g; }
      }
      tl[k * 33 + n4] = v.x; tl[k * 33 + n4 + 1] = v.y; tl[k * 33 + n4 + 2] = v.z; tl[k * 33 + n4 + 3] = v.w;
    }
  }
  __syncthreads();
  {
    const int n = tid >> 4, k8 = (tid & 15) * 8;
    uint4 o;
    o.x = pack2(tl[(k8 + 0) * 33 + n], tl[(k8 + 1) * 33 + n]);
    o.y = pack2(tl[(k8 + 2) * 33 + n], tl[(k8 + 3) * 33 + n]);
    o.z = pack2(tl[(k8 + 4) * 33 + n], tl[(k8 + 5) * 33 + n]);
    o.w = pack2(tl[(k8 + 6) * 33 + n], tl[(k8 + 7) * 33 + n]);
    *(uint4*)(dst + (size_t)(nrow0 + n) * K + k0 + k8) = o;
  }
}
constexpr int CONV_PER_LAYER = 2240 + 72 + 64 + 128 + 64 + 128 + 256;
constexpr int NCONV = CONV_PER_LAYER * DEPTH;
constexpr int NADA = DEPTH * 96;
constexpr int NROPE = 4096 * 48 / 512;

DI void phase_prep(const Params& p, char* smem) {
  const int tid = get_tid(p);
  float* fl = (float*)smem;
  for (int job = blockIdx.x; job < NCONV + NADA + NROPE; job += gridDim.x) {
    if (job < NCONV) {
      int l = job / CONV_PER_LAYER, j = job % CONV_PER_LAYER;
      if (j < 2240) {
        int nt = j >> 3, kt = j & 7;
        conv_tile(p.w_in + (size_t)l * DM * D_IN, D_IN, inproj_orig_col(nt * 32), kt * 128, nullptr,
                  p.wt_in() + (size_t)l * NIN * DM, DM, nt * 32, fl, tid);
      } else if ((j -= 2240) < 72) {
        int nt = j / 3, kt = j % 3;
        conv_tile(p.w_uq + (size_t)l * 384 * 768, 768, nt * 32, kt * 128, p.g_q + l * 384, p.wt_uq() + (size_t)l * 768 * 384,
                  384, nt * 32, fl, tid);
      } else if ((j -= 72) < 64) {
        int nt = j >> 1, kt = j & 1;
        conv_tile(p.w_ukv + (size_t)l * 256 * 1024, 1024, nt * 32, kt * 128, p.g_kv + l * 256,
                  p.wt_ukv() + (size_t)l * 1024 * 256, 256, nt * 32, fl, tid);
      } else if ((j -= 64) < 128) {
        int nt = j >> 2, kt = j & 3;
        conv_tile(p.w_pa + (size_t)l * 512 * 1024, 1024, nt * 32, kt * 128, nullptr, p.wt_pa() + (size_t)l * 1024 * 512, 512,
                  nt * 32, fl, tid);
      } else if ((j -= 128) < 64) {
        int nt = j >> 1, kt = j & 1;
        conv_tile(p.w_pb + (size_t)l * 256 * 1024, 1024, nt * 32, kt * 128, nullptr, p.wt_pb() + (size_t)l * 1024 * 256, 256,
                  nt * 32, fl, tid);
      } else if ((j -= 64) < 128) {
        int nt = j >> 2, kt = j & 3;
        conv_tile(p.w_pc + (size_t)l * 512 * 1024, 1024, nt * 32, kt * 128, nullptr, p.wt_pc() + (size_t)l * 1024 * 512, 512,
                  nt * 32, fl, tid);
      } else {
        j -= 128;
        int nt = j >> 3, kt = j & 7;
        conv_tile(p.w_out + (size_t)l * 1024 * 1024, 1024, nt * 32, kt * 128, nullptr, p.wt_out() + (size_t)l * 1024 * 1024,
                  1024, nt * 32, fl, tid);
      }
    } else if (job < NCONV + NADA) {
      int jb = job - NCONV;
      int l = jb / 96, j0 = (jb % 96) * 32;
      int jj = tid & 31, kp = tid >> 5;
      float* cs = fl;
      float* red = fl + 24 * 128;
      float acc[24];
#pragma unroll
      for (int b = 0; b < 24; ++b) acc[b] = 0.f;
      const float* W = p.w_ada + (size_t)l * DM * 3072 + j0 + jj;
      for (int ch = 0; ch < 8; ++ch) {
        __syncthreads();
        for (int e = tid; e < 24 * 128; e += 512) {
          int b = e >> 7, kk = e & 127;
          float cv = (b < 16) ? p.c_prompt[b * DM + ch * 128 + kk] : p.c_sample[(b - 16) * DM + ch * 128 + kk];
          cs[e] = siluf_(cv);
        }
        __syncthreads();
#pragma unroll 4
        for (int kk = kp * 8; kk < kp * 8 + 8; ++kk) {
          float w = W[(size_t)(ch * 128 + kk) * 3072];
#pragma unroll
          for (int b = 0; b < 24; ++b) acc[b] += cs[b * 128 + kk] * w;
        }
      }
      __syncthreads();
#pragma unroll
      for (int b = 0; b < 24; ++b) red[(kp * 24 + b) * 32 + jj] = acc[b];
      __syncthreads();
      for (int e = tid; e < 24 * 32; e += 512) {
        int b = e >> 5, j = e & 31;
        float s = 0.f;
#pragma unroll
        for (int q = 0; q < 16; ++q) s += red[(q * 24 + b) * 32 + j];
        p.mod()[((size_t)l * 24 + b) * 3072 + j0 + j] = s + p.b_ada[l * 3072 + j0 + j];
      }
    } else {
      int e = (job - NCONV - NADA) * 512 + tid;
      int pos = e / 48, f = e % 48;
      double base, inv = 1.0;
      int ex;
      if (f < 32) { base = 0.7498942093324559; ex = f; }
      else { base = 0.5623413251903491; ex = f - 32; }
      for (int i = 0; i < ex; ++i) inv *= base;
      double ang = (double)pos * inv;
      double n = rint(ang * 0.15915494309189535);
      float rr = (float)(ang - n * 6.283185307179586);
      float2 cs2 = make_float2(__cosf(rr), __sinf(rr));
      if (f < 32) p.ropeB()[pos * 32 + f] = cs2;
      else p.ropeA()[pos * 16 + (f - 32)] = cs2;
    }
  }
}

DI const float* x_row_in(const Params& p, int t) {
  return (t < NPTOK) ? p.x_prompt + (size_t)t * DM : p.x_sample + (size_t)(t - NPTOK) * DM;
}
DI void write_h(const Params& p, int l, int b, int tl, int lane, const float (&y)[16]) {
  float ss = 0.f;
#pragma unroll
  for (int i = 0; i < 16; ++i) ss += y[i] * y[i];
  ss = wave_sum(ss);
  float rinv = rsqrtf(ss * (1.f / DM) + EPS);
  const float* md = p.mod() + ((size_t)l * 24 + b) * 3072;
#pragma unroll
  for (int i = 0; i < 4; ++i) {
    int col = 4 * lane + 256 * i;
    float4 g = *(const float4*)(p.g_pre + l * DM + col);
    float4 sh = *(const float4*)(md + col);
    float4 sc = *(const float4*)(md + 1024 + col);
    st4(p.hbuf() + (size_t)tl * DM + col, y[4 * i + 0] * rinv * g.x * (1.f + sc.x) + sh.x,
        y[4 * i + 1] * rinv * g.y * (1.f + sc.y) + sh.y, y[4 * i + 2] * rinv * g.z * (1.f + sc.z) + sh.z,
        y[4 * i + 3] * rinv * g.w * (1.f + sc.w) + sh.w);
  }
}
DI void phase_norm0(const Params& p, int c, int S, int bbase) {
  const int tid_ = get_tid(p); const int lane = tid_ & 63, wv = tid_ >> 6;
  for (int tl = blockIdx.x * 8 + wv; tl < CT; tl += gridDim.x * 8) {
    const float* xr = x_row_in(p, c * CT + tl);
    float y[16];
#pragma unroll
    for (int i = 0; i < 4; ++i) {
      float4 v = *(const float4*)(xr + 4 * lane + 256 * i);
      y[4 * i] = v.x; y[4 * i + 1] = v.y; y[4 * i + 2] = v.z; y[4 * i + 3] = v.w;
    }
    write_h(p, 0, bbase + (tl >> (S == 2048 ? 11 : 12)), tl, lane, y);
  }
}
DI void phase_post(const Params& p, int c, int l, int S, int bbase) {
  const int tid_ = get_tid(p); const int lane = tid_ & 63, wv = tid_ >> 6;
  const int stride = gridDim.x * 8;
  for (int tl0 = blockIdx.x * 8 + wv; tl0 < CT; tl0 += 2 * stride) {
    const bool two = (tl0 + stride) < CT;
    const int tls[2] = {tl0, two ? tl0 + stride : tl0};
    float o[2][16], x[2][16], y[2][16];
    float ss[2] = {0.f, 0.f};
#pragma unroll
    for (int q = 0; q < 2; ++q) {
      const int tl = tls[q], t = c * CT + tl;
      const u16* orow = p.outh() + (size_t)tl * DM;
      const float* xr = (l == 0) ? x_row_in(p, t) : p.out + (size_t)t * DM;
#pragma unroll
      for (int i = 0; i < 4; ++i) {
        const uint2 v = *(const uint2*)(orow + 4 * lane + 256 * i);
        const float4 xv = *(const float4*)(xr + 4 * lane + 256 * i);
        o[q][4 * i] = bflo(v.x); o[q][4 * i + 1] = bfhi(v.x); o[q][4 * i + 2] = bflo(v.y); o[q][4 * i + 3] = bfhi(v.y);
        x[q][4 * i] = xv.x; x[q][4 * i + 1] = xv.y; x[q][4 * i + 2] = xv.z; x[q][4 * i + 3] = xv.w;
      }
    }
#pragma unroll
    for (int q = 0; q < 2; ++q) {
#pragma unroll
      for (int i = 0; i < 16; ++i) ss[q] += o[q][i] * o[q][i];
      ss[q] = wave_sum(ss[q]);
    }
#pragma unroll
    for (int q = 0; q < 2; ++q) {
      if (q == 1 && !two) break;
      const int tl = tls[q], t = c * CT + tl, b = bbase + (tl >> (S == 2048 ? 11 : 12));
      const float rinv = rsqrtf(ss[q] * (1.f / DM) + EPS);
      const float* md = p.mod() + ((size_t)l * 24 + b) * 3072 + 2048;
#pragma unroll
      for (int i = 0; i < 4; ++i) {
        int col = 4 * lane + 256 * i;
        float4 g = *(const float4*)(p.g_post + l * DM + col);
        float4 gt = *(const float4*)(md + col);
        float4 yv;
        yv.x = x[q][4 * i] + gt.x * (o[q][4 * i] * rinv * g.x);
        yv.y = x[q][4 * i + 1] + gt.y * (o[q][4 * i + 1] * rinv * g.y);
        yv.z = x[q][4 * i + 2] + gt.z * (o[q][4 * i + 2] * rinv * g.z);
        yv.w = x[q][4 * i + 3] + gt.w * (o[q][4 * i + 3] * rinv * g.w);
        *(float4*)(p.out + (size_t)t * DM + col) = yv;
        y[q][4 * i] = yv.x; y[q][4 * i + 1] = yv.y; y[q][4 * i + 2] = yv.z; y[q][4 * i + 3] = yv.w;
      }
      if (l + 1 < DEPTH) write_h(p, l + 1, b, tl, lane, y[q]);
    }
  }
}

struct HalfBar {
  volatile LDSP unsigned* cnt;
  unsigned target;
};
DI void half_sync(HalfBar& hb, int lane) {
  asm volatile("s_waitcnt vmcnt(0) lgkmcnt(0)" ::: "memory");
  hb.target += 4u;
  if (lane == 0) {
    __hip_atomic_fetch_add((LDSP unsigned*)hb.cnt, 1u, __ATOMIC_RELAXED, __HIP_MEMORY_SCOPE_WORKGROUP);
    while (__hip_atomic_load((LDSP unsigned*)hb.cnt, __ATOMIC_RELAXED, __HIP_MEMORY_SCOPE_WORKGROUP) < hb.target) __builtin_amdgcn_s_sleep(1);
  }
  asm volatile("s_waitcnt lgkmcnt(0)" ::: "memory");
}

constexpr int VSTR = 72;
constexpr int ATT_LDS = 128 * 104 * 2 + 128 * VSTR * 2 + 2048;
template <int MODE>
DI void attn_item(const Params& p, int item, int l, int lgS, char* smem, char* smem0, HalfBar& hb, bool dry = false) {
  const int S = 1 << lgS, lgq = lgS - 7;
  constexpr int DQK = (MODE == 0) ? 96 : 64;
  constexpr int KSTR = DQK + 8;
  constexpr int NKS = DQK / 16;
  constexpr int KCH = DQK / 8;
  constexpr int NKL = KCH * 64 / 256;
  constexpr bool SHARED = (MODE != 1);
  char* tbase = SHARED ? smem0 : smem;
  u16* Ks = (u16*)tbase;
  u16* Vs = (u16*)(tbase + 128 * 104 * 2);
  float* bias = (float*)(smem + 128 * 104 * 2 + 128 * VSTR * 2);
  const int tidS = get_tid(p);
  const int tid = tidS & 255, lane = tid & 63, w = tid >> 6, r = lane & 31, h = lane >> 5;

  int tb, nkt;
  const u16 *Qp, *Kb, *Vb;
  int kld, vld;
  int tlq;
  int dd = 1, L = 0, rc = 0, qb = 0, grp = 0, hj = 0;
  int rows = 0, rsU = 0, rsL = 0, rsT = 0, k0 = 0, qr = 0, qc = 0, rsq = 0, csq = 0, hd = 0;
  if constexpr (MODE == 0) {
    const int s = item >> (lgq + 3), rem = item & ((8 << lgq) - 1);
    hd = rem >> lgq;
    const int qblk = rem & ((1 << lgq) - 1);
    tb = s << lgS;
    tlq = tb + qblk * 128 + 32 * w + r;
    Qp = p.qa() + (size_t)tlq * 768 + hd * 96;
    Kb = p.ka() + hd * 96; kld = 768;
    Vb = p.va() + hd * 64; vld = 512;
    nkt = S >> 6;
  } else if constexpr (MODE == 1) {
    const int blk = item >> lgq, cb = item & ((1 << lgq) - 1);
    const int s = blk / 12, hh = blk % 12;
    grp = hh >> 2; hj = hh & 3;
    const int lgd = 2 * grp;
    dd = 1 << lgd;
    L = S >> lgd;
    const int lgn = lgq - lgd;
    rc = cb >> lgn; qb = cb & ((1 << lgn) - 1);
    tb = s << lgS;
    tlq = tb + rc + dd * (qb * 128 + 32 * w + r);
    Qp = p.qkvb() + (size_t)tlq * 2304 + hh * 64;
    Kb = p.qkvb() + 768 + hh * 64; kld = 2304;
    Vb = p.qkvb() + 1536 + hh * 64; vld = 2304;
    nkt = 4;
  } else {
    rows = S >> 6;
    const int s = item >> (lgq + 3), rem = item & ((8 << lgq) - 1);
    hd = rem >> lgq;
    const int R = rem & ((1 << lgq) - 1);
    tb = s << lgS;
    qr = 2 * R + (r >> 4); qc = 16 * w + (r & 15);
    tlq = tb + qr * 64 + qc;
    k0 = (w == 0) ? 0 : (w == 1 ? 8 : (w == 2 ? 24 : 32));
    rsU = min(max(2 * (R & ~1) - 4, 0), rows - 8);
    rsL = min(max(2 * R - 4, 0), rows - 8);
    rsT = min(max(2 * R + 1 - 4, 0), rows - 8) + 8;
    rsq = min(max(qr - 4, 0), rows - 8);
    csq = min(max(qc - 8, 0), 48);
    Qp = p.qkvc() + (size_t)tlq * 1536 + hd * 64;
    Kb = p.qkvc() + 512 + hd * 64; kld = 1536;
    Vb = p.qkvc() + 1024 + hd * 64; vld = 1536;
    nkt = 12;
  }

  __syncthreads();
  if constexpr (MODE == 2) {
    const float* bsrc = p.rpb + ((size_t)l * 8 + hd) * 465;
    for (int e = tid; e < 465; e += 256) bias[e] = bsrc[e] * LOG2E;
  }

  bf16x8 qf[NKS];
#pragma unroll
  for (int ks = 0; ks < NKS; ++ks) qf[ks] = *(const bf16x8*)(Qp + 16 * ks + 8 * h);

  u32x4 kreg[2 * NKL], vreg[4];
  auto key_tok = [&](int kt, int kk) -> int {
    if constexpr (MODE == 0) return tb + kt * 64 + kk;
    else if constexpr (MODE == 1) {
      int km = qb * 128 - 64 + kt * 64 + kk;
      km = min(max(km, 0), L - 1);
      return tb + rc + dd * km;
    } else {
      int krow = min(rsU + kt, rows - 1);
      return tb + krow * 64 + kk;
    }
  };
  unsigned koff[3], voff[2];
#pragma unroll
  for (int i = 0; i < 3; ++i) { const int id = tidS + 512 * i; koff[i] = (unsigned)((id / 12) * 768 + (id % 12) * 8); }
#pragma unroll
  for (int i = 0; i < 2; ++i) { const int id = tidS + 512 * i; voff[i] = (unsigned)((id >> 3) * 512 + (id & 7) * 8); }
  auto load_tile = [&](int kt2) {
    if constexpr (MODE == 0) {
      const u16* Kt = Kb + (size_t)(tb + kt2 * 128) * 768;
      const u16* Vt = Vb + (size_t)(tb + kt2 * 128) * 512;
#pragma unroll
      for (int i = 0; i < 3; ++i) kreg[i] = *(const u32x4*)(Kt + koff[i]);
#pragma unroll
      for (int i = 0; i < 2; ++i) vreg[i] = *(const u32x4*)(Vt + voff[i]);
      return;
    }
    if constexpr (MODE == 2) {
#pragma unroll
      for (int i = 0; i < 2; ++i) {
        const int id = tidS + 512 * i, k2 = id >> 3, cc = id & 7;
        const unsigned to = (unsigned)key_tok(2 * kt2 + (k2 >> 6), k2 & 63);
        kreg[i] = *(const u32x4*)(Kb + (to * (unsigned)kld + cc * 8));
        vreg[i] = *(const u32x4*)(Vb + (to * (unsigned)vld + cc * 8));
      }
      return;
    }
#pragma unroll
    for (int sub = 0; sub < 2; ++sub) {
      if constexpr (MODE == 0) {
      } else {
#pragma unroll
        for (int i = 0; i < NKL; ++i) {
          int id = tid + 256 * i;
          int kk = id / KCH, cc = id % KCH;
          kreg[sub * NKL + i] = *(const u32x4*)(Kb + (unsigned)(key_tok(2 * kt2 + sub, kk) * kld + cc * 8));
        }
#pragma unroll
        for (int i = 0; i < 2; ++i) {
          int id = tid + 256 * i;
          int kk = id >> 3, cc = id & 7;
          vreg[sub * 2 + i] = *(const u32x4*)(Vb + (unsigned)(key_tok(2 * kt2 + sub, kk) * vld + cc * 8));
        }
      }
    }
  };
  auto store_tile = [&]() {
    if constexpr (MODE == 0) {
#pragma unroll
      for (int i = 0; i < 3; ++i) { const int id = tidS + 512 * i; *(u32x4*)(Ks + (id / 12) * KSTR + (id % 12) * 8) = kreg[i]; }
#pragma unroll
      for (int i = 0; i < 2; ++i) { const int id = tidS + 512 * i; *(u32x4*)(Vs + (id >> 3) * VSTR + (id & 7) * 8) = vreg[i]; }
      return;
    }
    if constexpr (MODE == 2) {
#pragma unroll
      for (int i = 0; i < 2; ++i) {
        const int id = tidS + 512 * i, k2 = id >> 3, cc = id & 7;
        *(u32x4*)(Ks + k2 * KSTR + cc * 8) = kreg[i];
        *(u32x4*)(Vs + k2 * VSTR + cc * 8) = vreg[i];
      }
      return;
    }
#pragma unroll
    for (int sub = 0; sub < 2; ++sub) {
#pragma unroll
      for (int i = 0; i < NKL; ++i) {
        int id = tid + 256 * i;
        int kk = id / KCH, cc = id % KCH;
        *(u32x4*)(Ks + (64 * sub + kk) * KSTR + cc * 8) = kreg[sub * NKL + i];
      }
#pragma unroll
      for (int i = 0; i < 2; ++i) {
        int id = tid + 256 * i;
        int kk = id >> 3, cc = id & 7;
        *(u32x4*)(Vs + (64 * sub + kk) * VSTR + cc * 8) = vreg[sub * 2 + i];
      }
    }
  };

  f32x16 O[2];
#pragma unroll
  for (int i = 0; i < 16; ++i) { O[0][i] = 0.f; O[1][i] = 0.f; }
  float m = 0.f, lsum = 0.f;
  const int i16 = lane & 15, tq = i16 >> 2, tp = i16 & 3, tu = (lane >> 4) & 1;
  const u16* vtr = Vs + (4 * h + tq) * VSTR + 16 * tu + 4 * tp;

  const int nkt2 = (nkt + 1) >> 1;
  load_tile(0);
  for (int kt2 = 0; kt2 < nkt2; ++kt2) {
    __syncthreads();
    store_tile();
    __syncthreads();
#if PROBE_REP == 7
    if (kt2 + 1 < nkt2 && !dry) load_tile(kt2 + 1);
#else
    if (kt2 + 1 < nkt2) load_tile(kt2 + 1);
#endif
    f32x16 spre[2][2];
    if constexpr (MODE == 0) {
      const float negm0 = -m;
#pragma unroll
      for (int sb = 0; sb < 2; ++sb)
#pragma unroll
        for (int kg = 0; kg < 2; ++kg) {
#pragma unroll
          for (int i = 0; i < 16; ++i) spre[sb][kg][i] = negm0;
#pragma unroll
          for (int ks = 0; ks < NKS; ++ks) {
            bf16x8 kf = *(const bf16x8*)(Ks + (64 * sb + 32 * kg + r) * KSTR + 16 * ks + 8 * h);
            spre[sb][kg] = mfma(kf, qf[ks], spre[sb][kg]);
          }
        }
    }
#pragma unroll
   for (int sub = 0; sub < 2; ++sub) {
    const int kt = 2 * kt2 + sub;
    bool use = true;
    int kmb = 0;
    if constexpr (MODE == 1) {
      kmb = qb * 128 - 64 + kt * 64;
      const int qw = qb * 128 + 32 * w;
      use = !(kmb > qw + 95 || kmb + 63 < qw - 64 || kmb + 63 < 0 || kmb >= L);
    } else if constexpr (MODE == 2) {
      use = ((rsU + kt) >= rsL) && ((rsU + kt) < rsT);
    }
    if (use) {
      constexpr int NKG = (MODE == 2) ? 1 : 2;
      const int kofs = (MODE == 2) ? k0 : 0;
      f32x16 sacc[NKG];
      if constexpr (MODE == 0) {
#pragma unroll
        for (int kg = 0; kg < NKG; ++kg) sacc[kg] = spre[sub][kg];
      } else {
        const float negm = -m;
#pragma unroll
        for (int kg = 0; kg < NKG; ++kg) {
#pragma unroll
          for (int i = 0; i < 16; ++i) sacc[kg][i] = negm;
#pragma unroll
          for (int ks = 0; ks < NKS; ++ks) {
            bf16x8 kf = *(const bf16x8*)(Ks + (64 * sub + kofs + 32 * kg + r) * KSTR + 16 * ks + 8 * h);
            sacc[kg] = mfma(kf, qf[ks], sacc[kg]);
          }
        }
      }
      if constexpr (MODE == 1) {
        const int qm = qb * 128 + 32 * w + r;
#pragma unroll
        for (int kg = 0; kg < 2; ++kg)
#pragma unroll
          for (int i = 0; i < 16; ++i) {
            const int km = kmb + 32 * kg + crow(i, h);
            const int df = km - qm;
            const bool ok = (km >= 0) && (km < L) && (df <= 64) && (df >= -64);
            sacc[kg][i] = ok ? sacc[kg][i] : NEGBIG;
          }
      } else if constexpr (MODE == 2) {
        const int krow = rsU + kt;
        const bool rowok = (krow >= rsq) && (krow < rsq + 8);
        const float* brow = bias + min(max(krow - qr + 7, 0), 14) * 31;
#pragma unroll
        for (int i = 0; i < 16; ++i) {
          const int kc = k0 + crow(i, h);
          const bool ok = rowok && (kc >= csq) && (kc < csq + 16);
          const int co = min(max(kc - qc + 15, 0), 30);
          sacc[0][i] = ok ? sacc[0][i] + brow[co] : NEGBIG;
        }
      }
      float mx = sacc[0][0];
#pragma unroll
      for (int kg = 0; kg < NKG; ++kg)
#pragma unroll
        for (int i = 0; i < 16; ++i) mx = fmaxf(mx, sacc[kg][i]);
      mx = half_max(mx);
      if (__any(mx > 6.0f)) {
        const float off = fmaxf(mx, 0.f);
        const float alpha = __builtin_amdgcn_exp2f(-off);
        m += off;
        lsum *= alpha;
#pragma unroll
        for (int kg = 0; kg < NKG; ++kg)
#pragma unroll
          for (int i = 0; i < 16; ++i) sacc[kg][i] -= off;
#pragma unroll
        for (int i = 0; i < 16; ++i) { O[0][i] *= alpha; O[1][i] *= alpha; }
        if constexpr (MODE == 0) {
          if (sub == 0) {
#pragma unroll
            for (int kg = 0; kg < 2; ++kg)
#pragma unroll
              for (int i = 0; i < 16; ++i) spre[1][kg][i] -= off;
          }
        }
      }
      float ps = 0.f;
#pragma unroll
      for (int kg = 0; kg < NKG; ++kg)
#pragma unroll
        for (int i = 0; i < 16; ++i) {
          float pv = __builtin_amdgcn_exp2f(sacc[kg][i]);
          sacc[kg][i] = pv;
          ps += pv;
        }
      lsum += ps;
#pragma unroll
      for (int kg = 0; kg < NKG; ++kg)
#pragma unroll
        for (int s2 = 0; s2 < 2; ++s2) {
          uint4 pk;
          pk.x = pack2(sacc[kg][8 * s2 + 0], sacc[kg][8 * s2 + 1]);
          pk.y = pack2(sacc[kg][8 * s2 + 2], sacc[kg][8 * s2 + 3]);
          pk.z = pack2(sacc[kg][8 * s2 + 4], sacc[kg][8 * s2 + 5]);
          pk.w = pack2(sacc[kg][8 * s2 + 6], sacc[kg][8 * s2 + 7]);
          const bf16x8 pf = __builtin_bit_cast(bf16x8, pk);
#pragma unroll
          for (int dt = 0; dt < 2; ++dt) {
            const u16* va = vtr + (64 * sub + kofs + 32 * kg + 16 * s2) * VSTR + 32 * dt;
            s16x4 lo = __builtin_amdgcn_ds_read_tr16_b64_v4i16((LDSP s16x4*)(va));
            s16x4 hi = __builtin_amdgcn_ds_read_tr16_b64_v4i16((LDSP s16x4*)(va + 8 * VSTR));
            bf16x8 vf = __builtin_shufflevector(lo, hi, 0, 1, 2, 3, 4, 5, 6, 7);
            O[dt] = mfma(vf, pf, O[dt]);
          }
        }
    }
   }
  }
  const float ltot = half_add(lsum);
  const float inv = ltot > 0.f ? 1.f / ltot : 0.f;
  if (dry && inv != 12345.678f) return;
  u16* base;
  if constexpr (MODE == 1) base = p.ob() + ((size_t)grp * CT + tlq) * 256 + hj * 64;
  else if constexpr (MODE == 0) base = p.ga() + (size_t)tlq * 512 + hd * 64;
  else base = p.gc() + (size_t)tlq * 512 + hd * 64;
#pragma unroll
  for (int dt = 0; dt < 2; ++dt)
#pragma unroll
    for (int k = 0; k < 2; ++k) {
      float lo4[4], hi4[4];
#pragma unroll
      for (int jj = 0; jj < 4; ++jj) {
        auto rr = __builtin_amdgcn_permlane32_swap(__float_as_uint(O[dt][8 * k + jj]), __float_as_uint(O[dt][8 * k + 4 + jj]), false, false);
        lo4[jj] = __uint_as_float(rr[0]) * inv;
        hi4[jj] = __uint_as_float(rr[1]) * inv;
      }
      u16* a = base + 32 * dt + 16 * k + 8 * h;
      u32x4 o;
      if constexpr (MODE == 1) {
        o[0] = pack2(lo4[0], lo4[1]); o[1] = pack2(lo4[2], lo4[3]); o[2] = pack2(hi4[0], hi4[1]); o[3] = pack2(hi4[2], hi4[3]);
      } else {
        const u32x4 gv = *(const u32x4*)a;
        o[0] = pack2(lo4[0] * bflo(gv[0]), lo4[1] * bfhi(gv[0]));
        o[1] = pack2(lo4[2] * bflo(gv[1]), lo4[3] * bfhi(gv[1]));
        o[2] = pack2(hi4[0] * bflo(gv[2]), hi4[1] * bfhi(gv[2]));
        o[3] = pack2(hi4[2] * bflo(gv[3]), hi4[3] * bfhi(gv[3]));
      }
      *(u32x4*)a = o;
    }
  if constexpr (MODE == 1) {
    if (h == 0) p.lseb()[((size_t)grp * CT + tlq) * 4 + hj] = m + __log2f(ltot);
  }
}
#ifndef PROBE_REP
#define PROBE_REP 0
#endif
DI void phase_attn(const Params& p, int l, int lgS, char* smem, int which = 7, bool dry = false) {
  constexpr int N_MLA = (CT / 128) * 8;
  constexpr int N_NA = (CT / 128) * 8;
  constexpr int N_DIL = (CT / 128) * 12;
  const int half = __builtin_amdgcn_readfirstlane(get_tid(p) >> 8);
  char* sm = smem + half * ATT_LDS;
  HalfBar hb;
  hb.cnt = (volatile LDSP unsigned*)(sm + ATT_LDS - 16);
  hb.target = 0u;
  __syncthreads();
  if (gridDim.x == 256) {
    const int lgq = lgS - 7, cpr = 64 >> lgq;
    const int xcd = blockIdx.x & 7, slot = (blockIdx.x >> 3) * 2 + half;
    const int sub = slot & ((1 << lgq) - 1), cl = slot >> lgq;
#pragma unroll 1
    for (int ri = 0; ri < 7; ++ri) {
      const int rd = ri;
      const int kind = (rd < 2) ? 0 : (rd < 4 ? 2 : 1);
      const int rr = (rd < 2) ? rd : (rd < 4 ? rd - 2 : rd - 4);
      const int it = (((rr * 8 + xcd) * cpr + cl) << lgq) + sub;
      if (kind == 0) { if (which & 1) attn_item<0>(p, it, l, lgS, sm, smem, hb, dry); }
      else if (kind == 2) { if (which & 2) attn_item<2>(p, it, l, lgS, sm, smem, hb, dry); }
      else { if (which & 4) attn_item<1>(p, it, l, lgS, sm, smem, hb, dry); }
    }
  } else {
    for (int pr = blockIdx.x; pr < (N_MLA + N_NA + N_DIL) / 2; pr += gridDim.x) {
      const int it = 2 * pr + half;
      if (it < N_MLA) { if (which & 1) attn_item<0>(p, it, l, lgS, sm, smem, hb, dry); }
      else if (it < N_MLA + N_NA) { if (which & 2) attn_item<2>(p, it - N_MLA, l, lgS, sm, smem, hb, dry); }
      else { if (which & 4) attn_item<1>(p, it - N_MLA - N_NA, l, lgS, sm, smem, hb, dry); }
    }
  }
  __syncthreads();
}

DI void phase_dilcomb(const Params& p) {
  const int tid_ = get_tid(p);
  for (int e = blockIdx.x * 512 + tid_; e < CT * 32; e += gridDim.x * 512) {
    const int tl = e >> 5, j = (e >> 3) & 3, ch = e & 7;
    float l0 = p.lseb()[((size_t)0 * CT + tl) * 4 + j], l1 = p.lseb()[((size_t)1 * CT + tl) * 4 + j],
          l2 = p.lseb()[((size_t)2 * CT + tl) * 4 + j];
    float mx = fmaxf(l0, fmaxf(l1, l2));
    float w0 = __builtin_amdgcn_exp2f(l0 - mx), w1 = __builtin_amdgcn_exp2f(l1 - mx), w2 = __builtin_amdgcn_exp2f(l2 - mx);
    float iw = 1.f / (w0 + w1 + w2);
    w0 *= iw; w1 *= iw; w2 *= iw;
    const size_t off = (size_t)tl * 256 + j * 64 + ch * 8;
    uint4 a = *(const uint4*)(p.ob() + off), b = *(const uint4*)(p.ob() + (size_t)CT * 256 + off),
          c = *(const uint4*)(p.ob() + (size_t)2 * CT * 256 + off);
    uint4 gv = *(const uint4*)(p.gb() + off);
    uint4 o;
    o.x = pack2((w0 * bflo(a.x) + w1 * bflo(b.x) + w2 * bflo(c.x)) * bflo(gv.x),
                (w0 * bfhi(a.x) + w1 * bfhi(b.x) + w2 * bfhi(c.x)) * bfhi(gv.x));
    o.y = pack2((w0 * bflo(a.y) + w1 * bflo(b.y) + w2 * bflo(c.y)) * bflo(gv.y),
                (w0 * bfhi(a.y) + w1 * bfhi(b.y) + w2 * bfhi(c.y)) * bfhi(gv.y));
    o.z = pack2((w0 * bflo(a.z) + w1 * bflo(b.z) + w2 * bflo(c.z)) * bflo(gv.z),
                (w0 * bfhi(a.z) + w1 * bfhi(b.z) + w2 * bfhi(c.z)) * bfhi(gv.z));
    o.w = pack2((w0 * bflo(a.w) + w1 * bflo(b.w) + w2 * bflo(c.w)) * bflo(gv.w),
                (w0 * bfhi(a.w) + w1 * bfhi(b.w) + w2 * bfhi(c.w)) * bfhi(gv.w));
    *(uint4*)(p.gb() + off) = o;
  }
}

#define XB_TMO      128
#define XB_XCNT(j)  (256  + 64 * (j))
#define XB_XSUB(j)  (1280 + 64 * (j))
#define XB_XGEN(j)  (2304 + 64 * (j))
#define XB_TOP      3328
#define XB_TOPGEN   3392
#define XCD_BAR_WORDS 3456
#define XB_SPIN_CAP (1u << 18)
#define LAS __attribute__((address_space(3)))

__device__ __forceinline__ unsigned xb_ld(unsigned* p)              { return __hip_atomic_load(p, __ATOMIC_RELAXED, __HIP_MEMORY_SCOPE_AGENT); }
__device__ __forceinline__ unsigned xb_add(unsigned* p, unsigned v) { return __hip_atomic_fetch_add(p, v, __ATOMIC_RELAXED, __HIP_MEMORY_SCOPE_AGENT); }
__device__ __forceinline__ unsigned xb_xcc_id() { return (unsigned)__builtin_amdgcn_s_getreg((3 << 11) | 20) & 0xFu; }
#define XB_SPIN(cond, bar) do { unsigned _sp = 0; while (cond) { __builtin_amdgcn_s_sleep(1); \
    if ((++_sp & 255u) == 0u) { if (xb_ld(&(bar)[XB_TMO])) break; if (_sp > XB_SPIN_CAP) { atomicAdd(&(bar)[XB_TMO], 1u); break; } } } } while (0)

struct XcdBarrier {
    int wv;
    unsigned* bar; unsigned x;
    volatile LAS unsigned* st;
};

__device__ __forceinline__ XcdBarrier xcd_barrier_post(unsigned* bar, volatile LAS unsigned* st, int wv) {
    XcdBarrier b; b.wv = wv; b.bar = bar; b.x = xb_xcc_id(); b.st = st;
    if (tid_from_wave(b.wv) == 0) (void)xb_add(&bar[XB_XCNT(b.x)], 1u);
    return b;
}
__device__ __forceinline__ void xcd_barrier_complete(unsigned* bar, unsigned x, unsigned& nloc, unsigned& nx) {
    const unsigned G = gridDim.x * gridDim.y * gridDim.z;
    unsigned sum, cnt, mine, sp = 0u;
    for (;;) {
        sum = 0u; cnt = 0u; mine = 0u;
#pragma unroll
        for (unsigned j = 0; j < 16; ++j) { const unsigned c = xb_ld(&bar[XB_XCNT(j)]); sum += c; cnt += (c > 0u) ? 1u : 0u; mine = (j == x) ? c : mine; }
        if (sum == G) break;
        __builtin_amdgcn_s_sleep(1);
        if ((++sp & 255u) == 0u) { if (xb_ld(&bar[XB_TMO])) break; if (sp > XB_SPIN_CAP) { atomicAdd(&bar[XB_TMO], 1u); break; } }
    }
    nloc = mine > 0u ? mine : 1u; nx = cnt > 0u ? cnt : 1u;
}

__device__ __forceinline__ void xcd_barrier(const XcdBarrier& b) {
    asm volatile("s_waitcnt vmcnt(0)" ::: "memory");
    __syncthreads();
    if (tid_from_wave(b.wv) == 0) {
        unsigned* bar = b.bar;
        __builtin_amdgcn_s_waitcnt(0);
        unsigned nloc = b.st[0], nx = b.st[1];
        if (nloc == 0u) { xcd_barrier_complete(bar, b.x, nloc, nx); b.st[0] = nloc; b.st[1] = nx; }
        const unsigned old = xb_add(&bar[XB_XSUB(b.x)], 1u);
        const unsigned gen = old / nloc;
        if (old + 1u == (gen + 1u) * nloc) {
            __builtin_amdgcn_fence(__ATOMIC_RELEASE, "agent");
            asm volatile("s_waitcnt vmcnt(0)" ::: "memory");
            const unsigned og = xb_add(&bar[XB_TOP], 1u);
            const unsigned tg = og / nx;
            if (og + 1u == (tg + 1u) * nx) xb_add(&bar[XB_TOPGEN], 1u);
            else XB_SPIN(xb_ld(&bar[XB_TOPGEN]) == tg, bar);
            __builtin_amdgcn_fence(__ATOMIC_ACQUIRE, "agent");
            xb_add(&bar[XB_XGEN(b.x)], 1u);
            asm volatile("s_waitcnt vmcnt(0)" ::: "memory");
        } else {
            XB_SPIN(xb_ld(&bar[XB_XGEN(b.x)]) == gen, bar);
            __builtin_amdgcn_fence(__ATOMIC_ACQUIRE, "agent");
            asm volatile("s_waitcnt vmcnt(0)" ::: "memory");
        }
    }
    __syncthreads();
}


constexpr int SMEM_STAGE = pg8::STAGE_BYTES;
constexpr int SMEM_BYTES = SMEM_STAGE + 16;
#ifndef PROBE_REP
#define PROBE_REP 0
#endif
__global__ void __launch_bounds__(512, 2) mega_kernel(Params pk) {
  cg::grid_group grid = cg::this_grid();
  Params p = pk;
  {
    int w = __builtin_amdgcn_readfirstlane((int)threadIdx.x >> 6);
    asm volatile("" : "+s"(w));
    p.wv = w;
  }
  extern __shared__ __attribute__((aligned(16))) char smem[];
  volatile LAS unsigned* xst = (volatile LAS unsigned*)(smem + SMEM_STAGE);
  if (threadIdx.x < 4) xst[threadIdx.x] = 0u;
  __syncthreads();
  const XcdBarrier xb = xcd_barrier_post((unsigned*)(p.ws + OFF_BAR), xst, p.wv);
  phase_prep(p, smem);
  grid.sync();
#pragma unroll 1
  for (int c = 0; c < NCHUNK; ++c) {
    const int S = (c < 2) ? 2048 : 4096;
    const int bbase = (c < 2) ? c * 8 : 16 + (c - 2) * 4;
    if (c == 0) {
      phase_norm0(p, c, S, bbase);
      xcd_barrier(xb);
    }
#pragma unroll 1
    for (int l = 0; l < DEPTH; ++l) {
      run_gemm<NIN, DM>(smem, p.hbuf(), p.wt_in() + (size_t)l * NIN * DM, EpiInproj{p, S, true});
      xcd_barrier(xb);
#if PROBE_REP == 1
      run_gemm<NIN, DM>(smem, p.hbuf(), p.wt_in() + (size_t)l * NIN * DM, EpiInproj{p, S, false});
      xcd_barrier(xb);
#endif
      run_gemm<768, 384>(smem, p.cq(), p.wt_uq() + (size_t)l * 768 * 384, EpiUp<true>{p, S});
      run_gemm<1024, 256>(smem, p.ckv(), p.wt_ukv() + (size_t)l * 1024 * 256, EpiUp<false>{p, S});
      phase_attn(p, l, (c < 2) ? 11 : 12, smem, 6);
      xcd_barrier(xb);
#if PROBE_REP == 2 || PROBE_REP == 7
      phase_attn(p, l, (c < 2) ? 11 : 12, smem, 1, true);
      xcd_barrier(xb);
#elif PROBE_REP == 3
      phase_attn(p, l, (c < 2) ? 11 : 12, smem, 6, true);
      xcd_barrier(xb);
#elif PROBE_REP == 4
      run_gemm<768, 384>(smem, p.cq(), p.wt_uq() + (size_t)l * 768 * 384, EpiUp<true>{p, S});
      run_gemm<1024, 256>(smem, p.ckv(), p.wt_ukv() + (size_t)l * 1024 * 256, EpiUp<false>{p, S});
      xcd_barrier(xb);
#endif
      phase_attn(p, l, (c < 2) ? 11 : 12, smem, 1);
      phase_dilcomb(p);
      xcd_barrier(xb);
      run_gemm<1024, 512>(smem, p.ga(), p.wt_pa() + (size_t)l * 1024 * 512, EpiBranch<0>{p});
      run_gemm<1024, 256>(smem, p.gb(), p.wt_pb() + (size_t)l * 1024 * 256, EpiBranch<1>{p});
      run_gemm<1024, 512>(smem, p.gc(), p.wt_pc() + (size_t)l * 1024 * 512, EpiBranch<2>{p});
      xcd_barrier(xb);
      run_gemm<1024, 1024>(smem, p.mixed(), p.wt_out() + (size_t)l * 1024 * 1024, EpiOut{p});
      xcd_barrier(xb);
#if PROBE_REP == 5
      run_gemm<1024, 512>(smem, p.ga(), p.wt_pa() + (size_t)l * 1024 * 512, EpiBranch<0>{p});
      run_gemm<1024, 256>(smem, p.gb(), p.wt_pb() + (size_t)l * 1024 * 256, EpiBranch<1>{p});
      run_gemm<1024, 512>(smem, p.gc(), p.wt_pc() + (size_t)l * 1024 * 512, EpiBranch<2>{p});
      xcd_barrier(xb);
      run_gemm<1024, 1024>(smem, p.mixed(), p.wt_out() + (size_t)l * 1024 * 1024, EpiOut{p});
      xcd_barrier(xb);
#endif
      phase_post(p, c, l, S, bbase);
      if (l == DEPTH - 1 && c + 1 < NCHUNK)
        phase_norm0(p, c + 1, (c + 1 < 2) ? 2048 : 4096, (c + 1 < 2) ? (c + 1) * 8 : 16 + (c + 1 - 2) * 4);
      xcd_barrier(xb);
#if PROBE_REP == 6
#pragma unroll 1
      for (int q = 0; q < 10; ++q) xcd_barrier(xb);
#endif
    }
  }
}

extern "C" void kernel_launch(void* const* d_in, const int* in_sizes, int n_in, void* d_out, int out_size, void* d_ws,
                              size_t ws_size, hipStream_t stream) {
  static int grid_blocks = 0;
  if (!grid_blocks) {
    int dev = 0, cus = 0, per_cu = 0;
    (void)hipGetDevice(&dev);
    (void)hipDeviceGetAttribute(&cus, hipDeviceAttributeMultiprocessorCount, dev);
    (void)hipFuncSetAttribute((const void*)mega_kernel, hipFuncAttributeMaxDynamicSharedMemorySize, SMEM_BYTES);
    (void)hipOccupancyMaxActiveBlocksPerMultiprocessor(&per_cu, mega_kernel, 512, SMEM_BYTES);
    if (per_cu > 1) per_cu = 1;
    if (per_cu < 1) per_cu = 1;
    grid_blocks = cus * per_cu;
  }
  Params p;
  memset(&p, 0, sizeof(p));
  p.x_prompt = (const float*)d_in[0];  p.x_sample = (const float*)d_in[1];
  p.c_prompt = (const float*)d_in[2];  p.c_sample = (const float*)d_in[3];
  p.w_ada = (const float*)d_in[4];     p.b_ada = (const float*)d_in[5];
  p.g_pre = (const float*)d_in[6];     p.g_post = (const float*)d_in[7];
  p.w_in = (const float*)d_in[8];      p.g_q = (const float*)d_in[9];
  p.w_uq = (const float*)d_in[10];     p.g_kv = (const float*)d_in[11];
  p.w_ukv = (const float*)d_in[12];    p.rpb = (const float*)d_in[13];
  p.w_pa = (const float*)d_in[14];     p.w_pb = (const float*)d_in[15];
  p.w_pc = (const float*)d_in[16];     p.w_out = (const float*)d_in[17];
  p.out = (float*)d_out;
  p.ws = (char*)d_ws;
  if (WS_NEEDED > ws_size) fprintf(stderr, "workspace too small: need %zu have %zu\n", (size_t)WS_NEEDED, ws_size);
  (void)hipMemsetAsync((char*)d_ws + OFF_BAR, 0, BAR_BYTES, stream);
  void* args[] = {&p};
  hipError_t e = hipLaunchCooperativeKernel((void*)mega_kernel, dim3(grid_blocks), dim3(512), args, SMEM_BYTES, stream);
  if (e != hipSuccess) fprintf(stderr, "cooperative launch failed: %s (grid %d)\n", hipGetErrorString(e), grid_blocks);
}
```

```cpp
#include <hip/hip_runtime.h>
#include <hip/hip_cooperative_groups.h>
#include <stdint.h>
#include <string.h>
#include <stdio.h>
namespace cg = cooperative_groups;
#ifndef PROBE_REP
#define PROBE_REP 0
#endif

typedef unsigned short u16;
typedef short bf16x8 __attribute__((ext_vector_type(8)));
typedef short s16x4 __attribute__((ext_vector_type(4)));
typedef float f32x16 __attribute__((ext_vector_type(16)));
typedef uint32_t u32x4 __attribute__((ext_vector_type(4)));
typedef __bf16 bf2_t __attribute__((ext_vector_type(2)));
typedef float f2_t __attribute__((ext_vector_type(2)));
#define DI __device__ __forceinline__
#define LDSP __attribute__((address_space(3)))

constexpr int DM = 1024;
constexpr int DEPTH = 4;
constexpr int NPTOK = 32768;
constexpr int NTOK = 65536;
constexpr int CT = 16384;
constexpr int NCHUNK = NTOK / CT;
constexpr int NIN = 8960;
constexpr int D_IN = 8864;
constexpr float EPS = 1e-6f;
constexpr float LOG2E = 1.4426950408889634f;
constexpr float QS_A = 0.10206207261596577f * LOG2E;
constexpr float QS_64 = 0.125f * LOG2E;
constexpr float NEGBIG = -1e30f;

constexpr int SEC_QKVB = 0, SEC_QKVC = 2304, SEC_MG = 3840, SEC_GA = 6912, SEC_GB = 7424, SEC_GC = 7680,
              SEC_CQ = 8192, SEC_CKV = 8576, SEC_KR = 8832, SEC_PAD = 8896;

constexpr size_t al256(size_t x) { return (x + 255) & ~(size_t)255; }
constexpr size_t OFF_WT_IN = 0;
constexpr size_t OFF_WT_UQ = OFF_WT_IN + al256((size_t)DEPTH * NIN * DM * 2);
constexpr size_t OFF_WT_UKV = OFF_WT_UQ + al256((size_t)DEPTH * 768 * 384 * 2);
constexpr size_t OFF_WT_PA = OFF_WT_UKV + al256((size_t)DEPTH * 1024 * 256 * 2);
constexpr size_t OFF_WT_PB = OFF_WT_PA + al256((size_t)DEPTH * 1024 * 512 * 2);
constexpr size_t OFF_WT_PC = OFF_WT_PB + al256((size_t)DEPTH * 1024 * 256 * 2);
constexpr size_t OFF_WT_OUT = OFF_WT_PC + al256((size_t)DEPTH * 1024 * 512 * 2);
constexpr size_t OFF_MOD = OFF_WT_OUT + al256((size_t)DEPTH * 1024 * 1024 * 2);
constexpr size_t OFF_ROPEB = OFF_MOD + al256((size_t)DEPTH * 24 * 3072 * 4);
constexpr size_t OFF_ROPEA = OFF_ROPEB + al256((size_t)4096 * 32 * 8);
constexpr size_t OFF_HBUF = OFF_ROPEA + al256((size_t)4096 * 16 * 8);
constexpr size_t OFF_QKVB = OFF_HBUF + al256((size_t)CT * 1024 * 2);
constexpr size_t OFF_QKVC = OFF_QKVB + al256((size_t)CT * 2304 * 2);
constexpr size_t OFF_MG = OFF_QKVC + al256((size_t)CT * 1536 * 2);
constexpr size_t OFF_GA = OFF_MG + al256((size_t)CT * 3072 * 2);
constexpr size_t OFF_GB = OFF_GA + al256((size_t)CT * 512 * 2);
constexpr size_t OFF_GC = OFF_GB + al256((size_t)CT * 256 * 2);
constexpr size_t OFF_CQ = OFF_GC + al256((size_t)CT * 512 * 2);
constexpr size_t OFF_CKV = OFF_CQ + al256((size_t)CT * 384 * 2);
constexpr size_t OFF_KA = OFF_CKV + al256((size_t)CT * 256 * 2);
constexpr size_t OFF_VA = OFF_KA + al256((size_t)CT * 768 * 2);
constexpr size_t OFF_OB = OFF_VA + al256((size_t)CT * 512 * 2);
constexpr size_t OFF_LSEB = OFF_OB + al256((size_t)3 * CT * 256 * 2);
constexpr size_t OFF_RSQ = OFF_LSEB + al256((size_t)3 * CT * 4 * 4);
constexpr size_t OFF_RSKV = OFF_RSQ + al256((size_t)CT * 12 * 4);
constexpr size_t OFF_BAR = OFF_RSKV + al256((size_t)CT * 8 * 4);
constexpr size_t BAR_BYTES = 3456 * 4;
constexpr size_t WS_NEEDED = OFF_BAR + al256(BAR_BYTES);

DI int tid_from_wave(int wv);
struct Params {
  const float *x_prompt, *x_sample, *c_prompt, *c_sample, *w_ada, *b_ada, *g_pre, *g_post, *w_in, *g_q, *w_uq, *g_kv,
      *w_ukv, *rpb, *w_pa, *w_pb, *w_pc, *w_out;
  float* out;
  char* ws;
  int wv, pad_;
  DI u16* wt_in() const { return (u16*)(ws + OFF_WT_IN); }
  DI u16* wt_uq() const { return (u16*)(ws + OFF_WT_UQ); }
  DI u16* wt_ukv() const { return (u16*)(ws + OFF_WT_UKV); }
  DI u16* wt_pa() const { return (u16*)(ws + OFF_WT_PA); }
  DI u16* wt_pb() const { return (u16*)(ws + OFF_WT_PB); }
  DI u16* wt_pc() const { return (u16*)(ws + OFF_WT_PC); }
  DI u16* wt_out() const { return (u16*)(ws + OFF_WT_OUT); }
  DI float* mod() const { return (float*)(ws + OFF_MOD); }
  DI float2* ropeB() const { return (float2*)(ws + OFF_ROPEB); }
  DI float2* ropeA() const { return (float2*)(ws + OFF_ROPEA); }
  DI u16* hbuf() const { return (u16*)(ws + OFF_HBUF); }
  DI u16* qa() const { return (u16*)(ws + OFF_HBUF); }
  DI u16* qkvb() const { return (u16*)(ws + OFF_QKVB); }
  DI u16* outh() const { return (u16*)(ws + OFF_QKVB); }
  DI u16* qkvc() const { return (u16*)(ws + OFF_QKVC); }
  DI u16* mixed() const { return (u16*)(ws + OFF_QKVC); }
  DI u16* mg() const { return (u16*)(ws + OFF_MG); }
  DI u16* ga() const { return (u16*)(ws + OFF_GA); }
  DI u16* gb() const { return (u16*)(ws + OFF_GB); }
  DI u16* gc() const { return (u16*)(ws + OFF_GC); }
  DI u16* cq() const { return (u16*)(ws + OFF_CQ); }
  DI u16* ckv() const { return (u16*)(ws + OFF_CKV); }
  DI u16* ka() const { return (u16*)(ws + OFF_KA); }
  DI u16* va() const { return (u16*)(ws + OFF_VA); }
  DI u16* ob() const { return (u16*)(ws + OFF_OB); }
  DI float* lseb() const { return (float*)(ws + OFF_LSEB); }
  DI float* rowss_q() const { return (float*)(ws + OFF_RSQ); }
  DI float* rowss_kv() const { return (float*)(ws + OFF_RSKV); }
};

DI int get_tid(const Params& p) { return tid_from_wave(p.wv); }

DI uint32_t pack2(float a, float b) {
  f2_t v = {a, b};
  bf2_t r = __builtin_convertvector(v, bf2_t);
  return __builtin_bit_cast(uint32_t, r);
}
DI float bflo(uint32_t u) { return __uint_as_float(u << 16); }
DI float bfhi(uint32_t u) { return __uint_as_float(u & 0xffff0000u); }
DI void st4(u16* dst, float a, float b, float c, float d) {
  uint2 v;
  v.x = pack2(a, b);
  v.y = pack2(c, d);
  *(uint2*)dst = v;
}
DI float sigmoidf_(float x) { return 1.f / (1.f + __expf(-x)); }
DI float siluf_(float x) { return x / (1.f + __expf(-x)); }
DI int tid_from_wave(int wv) {
  int lane;
  asm volatile("v_mbcnt_lo_u32_b32 %0, -1, 0\n\tv_mbcnt_hi_u32_b32 %0, -1, %0" : "=v"(lane));
  return (wv << 6) | lane;
}
DI int crow(int reg, int h) { return (reg & 3) + 8 * (reg >> 2) + 4 * h; }
DI f32x16 mfma(bf16x8 a, bf16x8 b, f32x16 c) { return __builtin_amdgcn_mfma_f32_32x32x16_bf16(a, b, c, 0, 0, 0); }
template <int K>
DI float swz_xor(float v) { return __int_as_float(__builtin_amdgcn_ds_swizzle(__float_as_int(v), (K << 10) | 0x1f)); }
DI float half_add(float v) {
  auto r = __builtin_amdgcn_permlane32_swap(__float_as_uint(v), __float_as_uint(v), false, false);
  return __uint_as_float(r[0]) + __uint_as_float(r[1]);
}
DI float half_max(float v) {
  auto r = __builtin_amdgcn_permlane32_swap(__float_as_uint(v), __float_as_uint(v), false, false);
  return fmaxf(__uint_as_float(r[0]), __uint_as_float(r[1]));
}
DI float wave_sum(float v) {
  v += swz_xor<1>(v); v += swz_xor<2>(v); v += swz_xor<4>(v); v += swz_xor<8>(v); v += swz_xor<16>(v);
  return half_add(v);
}

namespace pg8 {
#define PG8_LAS __attribute__((address_space(3)))
typedef unsigned short bf16_t;
typedef short bf16x8 __attribute__((ext_vector_type(8)));
typedef float f32x4 __attribute__((ext_vector_type(4)));
typedef unsigned u32x4 __attribute__((ext_vector_type(4)));
constexpr int BM = 256, BK = 64, HALF = 128, HTB = HALF * BK * 2  , STAGE_BYTES = 8 * HTB, NXCD = 8, WGM = 8;

__host__ __device__ __forceinline__ int lds_byte(int r, int c) { const int st = (r >> 4) * 2 + (c >> 5), rr = r & 15, cc = c & 31, ob = rr * 64 + cc * 2; return st * 1024 + (ob ^ (((ob >> 9) & 1) << 5)); }
__host__ __device__ __forceinline__ void stage_rc(int b, int& R, int& C) { const int st = b / 1024, sb = b % 1024, swz = sb ^ (((sb >> 9) & 1) << 5); R = (st >> 1) * 16 + swz / 64; C = (st & 1) * 32 + (swz % 64) / 2; }
__host__ __device__ __forceinline__ int perm32(int rho) { const int n = rho >> 4, i = rho & 15; return 8 * (i >> 2) + 4 * n + (i & 3); }

struct Unit { int pm, pn; };
struct Gemm { const bf16_t* A; const bf16_t* Bt; int M, N, K; };

struct StaticOrder {
    int nM, nN, nwg, G, c;
    __host__ __device__ void init(int M, int N, int G_, int c_) { nM = M / BM; nN = N / BM; nwg = nM * nN; G = G_; c = c_; }
    __host__ __device__ bool next(int i, Unit& u) const {
        const long L = (long)i * G + c; if (L >= nwg) return false;
        int wgid = (int)L; { const int q = nwg / NXCD, r = nwg % NXCD, xcd = wgid % NXCD, off = wgid / NXCD; wgid = (xcd < r ? xcd * (q + 1) : r * (q + 1) + (xcd - r) * q) + off; }
        const int nig = WGM * nN, gid = wgid / nig, fm = gid * WGM, gsz = (nM - fm) < WGM ? (nM - fm) : WGM;
        u.pm = fm + ((wgid % nig) % gsz); u.pn = (wgid % nig) / gsz; return true;
    }
    __device__ __forceinline__ void a_ready(const Unit&) const {}
    __device__ __forceinline__ void done(const Unit&) const {}
};

template <class Epi, class Sched, bool STAMP = false>
__device__ __forceinline__ void gemm_phase(PG8_LAS unsigned char* lds, const Gemm g, const Sched& S, const Epi& E, unsigned long long* stamps) {
    const int tid = get_tid(E.p), wid = __builtin_amdgcn_readfirstlane(tid >> 6), lane = tid & 63, wr = wid >> 2, wc = wid & 3, fr = lane & 15, fq = lane >> 4;
    const int K = g.K, nt = K / BK;
    int ts_lo = 0, ts_hi = 0, nts = 0; const unsigned long long rt_entry = STAMP ? (unsigned long long)wall_clock64() : 0ull;
#define PG8_STAMP() do { if (STAMP && wid == 0 && nts < 64) { const unsigned long long _c = (unsigned long long)clock64(); \
        ts_lo = (lane == nts) ? (int)(unsigned)_c : ts_lo; ts_hi = (lane == nts) ? (int)(unsigned)(_c >> 32) : ts_hi; ++nts; } } while (0)
    PG8_STAMP();
    unsigned voffA[2], voffB[2];
#pragma unroll
    for (int i = 0; i < 2; ++i) { int R, C; stage_rc(tid * 16 + i * 8192, R, C); const int Rb = Epi::PERM ? ((R & ~31) + perm32(R & 31)) : R;
        voffA[i] = (unsigned)(R * K + C) * 2u; voffB[i] = (unsigned)(Rb * K + C) * 2u; }
    const size_t kstep = (size_t)(BK * 2);
    const size_t hstep = (size_t)HALF * K * 2;
    const size_t tstep = 2 * hstep;
    const unsigned ldsw = (unsigned)wid * 1024u;
    const int aoff = lds_byte(wr * 64 + fr, fq * 8), boff = lds_byte(wc * 32 + fr, fq * 8);
#define PG8_SA(b, h) (((b) * 2 + (h)) * HTB)
#define PG8_SB(b, h) ((4 + (b) * 2 + (h)) * HTB)
#define PG8_STAGE(bufoff, gbase, voff) do { _Pragma("unroll") for (int _i = 0; _i < 2; ++_i) \
        __builtin_amdgcn_global_load_lds((const unsigned*)((const char*)(gbase) + (voff)[_i]), (PG8_LAS unsigned*)(lds + (bufoff) + ldsw + _i * 8192), 16, 0, 0); } while (0)
#define PG8_LDA(dst, b, h) do { _Pragma("unroll") for (int m = 0; m < 4; ++m) _Pragma("unroll") for (int k = 0; k < 2; ++k) dst[m][k] = *(const PG8_LAS bf16x8*)(lds + PG8_SA(b, h) + aoff + m * 2048 + k * 1024); } while (0)
#define PG8_LDB(dst, b, h) do { _Pragma("unroll") for (int n = 0; n < 2; ++n) _Pragma("unroll") for (int k = 0; k < 2; ++k) dst[n][k] = *(const PG8_LAS bf16x8*)(lds + PG8_SB(b, h) + boff + n * 2048 + k * 1024); } while (0)
#define PG8_MMA(ai, bj, At, Bt) do { __builtin_amdgcn_s_setprio(1); _Pragma("unroll") for (int m = 0; m < 4; ++m) _Pragma("unroll") for (int n = 0; n < 2; ++n) _Pragma("unroll") for (int k = 0; k < 2; ++k) \
        acc[ai][bj][m][n] = __builtin_amdgcn_mfma_f32_16x16x32_bf16(Bt[n][k], At[m][k], acc[ai][bj][m][n], 0, 0, 0); __builtin_amdgcn_s_setprio(0); } while (0)
#define PG8_WAIT_V(n) asm volatile("s_waitcnt vmcnt(" #n ")" ::: "memory")
#define PG8_WAIT_L(n) asm volatile("s_waitcnt lgkmcnt(" #n ")" ::: "memory")
#define PG8_BAR __builtin_amdgcn_s_barrier()
#define PG8_SCHED __builtin_amdgcn_sched_barrier(0)
    Unit cur, nxt; int ui = 0;
    if (!S.next(0, cur)) return;
    f32x4 acc[2][2][4][2];
#pragma unroll
    for (int a = 0; a < 2; ++a)
#pragma unroll
        for (int b = 0; b < 2; ++b)
#pragma unroll
            for (int m = 0; m < 4; ++m)
#pragma unroll
                for (int n = 0; n < 2; ++n) acc[a][b][m][n] = (f32x4){0.f, 0.f, 0.f, 0.f};
    bf16x8 At[4][2], B0[2][2], B1[2][2];
    const char* cA = (const char*)g.A + (size_t)cur.pm * tstep; const char* cB = (const char*)g.Bt + (size_t)cur.pn * tstep;
    S.a_ready(cur);
    PG8_STAGE(PG8_SB(0, 0), cB, voffB); PG8_STAGE(PG8_SA(0, 0), cA, voffA); PG8_STAGE(PG8_SB(0, 1), cB + hstep, voffB); PG8_STAGE(PG8_SA(0, 1), cA + hstep, voffA);
    if (wr == 1) PG8_BAR;
    PG8_WAIT_V(4); PG8_BAR;
    PG8_STAGE(PG8_SB(1, 0), cB + kstep, voffB); PG8_STAGE(PG8_SA(1, 0), cA + kstep, voffA); PG8_STAGE(PG8_SB(1, 1), cB + hstep + kstep, voffB);
    PG8_WAIT_V(6); PG8_BAR;
    PG8_STAMP();
    for (;;) {
        const bool has_next = S.next(ui + 1, nxt);
        const char* nA = has_next ? (const char*)g.A + (size_t)nxt.pm * tstep : cA; const char* nB = has_next ? (const char*)g.Bt + (size_t)nxt.pn * tstep : cB;
        for (int t = 0; t < nt; t += 2) {
            const bool last = (t == nt - 2);
            const char* a1 = cA + (size_t)(t + 1) * kstep;
            const char* a2 = last ? nA : cA + (size_t)(t + 2) * kstep; const char* b2 = last ? nB : cB + (size_t)(t + 2) * kstep;
            const char* a3 = a2 + kstep; const char* b3 = b2 + kstep;
            if (last && has_next) S.a_ready(nxt);
            PG8_LDB(B0, 0, 0); PG8_SCHED; PG8_LDA(At, 0, 0); PG8_STAGE(PG8_SA(1, 1), a1 + hstep, voffA);
            PG8_WAIT_L(8); PG8_BAR; PG8_WAIT_L(0); PG8_MMA(0, 0, At, B0); PG8_BAR; PG8_SCHED;
            PG8_LDB(B1, 0, 1); PG8_STAGE(PG8_SB(0, 0), b2, voffB);
            PG8_BAR; PG8_WAIT_L(0); PG8_MMA(0, 1, At, B1); PG8_BAR;
            PG8_LDA(At, 0, 1); PG8_STAGE(PG8_SA(0, 0), a2, voffA);
            PG8_BAR; PG8_WAIT_L(0); PG8_MMA(1, 0, At, B0); PG8_BAR; PG8_SCHED;
            PG8_STAGE(PG8_SB(0, 1), b2 + hstep, voffB);
            PG8_WAIT_V(6); PG8_BAR; PG8_MMA(1, 1, At, B1); PG8_BAR;
            PG8_LDB(B0, 1, 0); PG8_SCHED; PG8_LDA(At, 1, 0); PG8_STAGE(PG8_SA(0, 1), a2 + hstep, voffA);
            PG8_WAIT_L(8); PG8_BAR; PG8_WAIT_L(0); PG8_MMA(0, 0, At, B0); PG8_BAR; PG8_SCHED;
            PG8_LDB(B1, 1, 1); PG8_STAGE(PG8_SB(1, 0), b3, voffB);
            PG8_BAR; PG8_WAIT_L(0); PG8_MMA(0, 1, At, B1); PG8_BAR;
            PG8_LDA(At, 1, 1); PG8_STAGE(PG8_SA(1, 0), a3, voffA);
            PG8_BAR; PG8_WAIT_L(0); PG8_MMA(1, 0, At, B0); PG8_BAR; PG8_SCHED;
            PG8_STAGE(PG8_SB(1, 1), b3 + hstep, voffB);
            PG8_WAIT_V(6); PG8_BAR; PG8_MMA(1, 1, At, B1); PG8_BAR;
        }
        PG8_STAMP();
        if constexpr (!Epi::AFTER_DRAIN) { E(acc, cur, wr, wc, fr, fq); S.done(cur); }
        PG8_STAMP();
        if (!has_next) break;
#pragma unroll
        for (int a = 0; a < 2; ++a)
#pragma unroll
            for (int b = 0; b < 2; ++b)
#pragma unroll
                for (int m = 0; m < 4; ++m)
#pragma unroll
                    for (int n = 0; n < 2; ++n) acc[a][b][m][n] = (f32x4){0.f, 0.f, 0.f, 0.f};
        cur = nxt; cA = nA; cB = nB; ++ui;
    }
    PG8_WAIT_V(0);
    if (wr == 0) PG8_BAR;
    PG8_BAR;
    if constexpr (Epi::AFTER_DRAIN) { E.fused(acc, cur, wr, wc, fr, fq, lds, wid, lane); S.done(cur); }
    PG8_STAMP();
    if (STAMP && wid == 0) { stamps[lane] = lane < nts ? (((unsigned long long)(unsigned)ts_hi << 32) | (unsigned)ts_lo) : 0ull;
        if (lane == 62) stamps[62] = rt_entry; if (lane == 63) stamps[63] = (unsigned long long)wall_clock64(); }
#undef PG8_STAMP
#undef PG8_SA
#undef PG8_SB
#undef PG8_STAGE
#undef PG8_LDA
#undef PG8_LDB
#undef PG8_MMA
#undef PG8_WAIT_V
#undef PG8_WAIT_L
#undef PG8_BAR
#undef PG8_SCHED
}
}


DI void st4v(u16* dst, const pg8::f32x4& v) { st4(dst, v[0], v[1], v[2], v[3]); }

DI void st8(u16* dst, const pg8::f32x4& a, const pg8::f32x4& b) {
  uint4 v;
  v.x = pack2(a[0], a[1]); v.y = pack2(a[2], a[3]); v.z = pack2(b[0], b[1]); v.w = pack2(b[2], b[3]);
  *(uint4*)dst = v;
}
DI float fsig(float x) { return __builtin_amdgcn_rcpf(1.f + __builtin_amdgcn_exp2f(-LOG2E * x)); }
DI pg8::f32x4 sig4(const pg8::f32x4& a) { return (pg8::f32x4){fsig(a[0]), fsig(a[1]), fsig(a[2]), fsig(a[3])}; }
DI pg8::f32x4 silu4(const pg8::f32x4& a) { return (pg8::f32x4){a[0] * fsig(a[0]), a[1] * fsig(a[1]), a[2] * fsig(a[2]), a[3] * fsig(a[3])}; }
DI pg8::f32x4 rope_lo(const pg8::f32x4& x1, const pg8::f32x4& x2, const float4& t0, const float4& t1) {
  return (pg8::f32x4){x1[0] * t0.x - x2[0] * t0.y, x1[1] * t0.z - x2[1] * t0.w, x1[2] * t1.x - x2[2] * t1.y, x1[3] * t1.z - x2[3] * t1.w};
}
DI pg8::f32x4 rope_hi(const pg8::f32x4& x1, const pg8::f32x4& x2, const float4& t0, const float4& t1) {
  return (pg8::f32x4){x2[0] * t0.x + x1[0] * t0.y, x2[1] * t0.z + x1[1] * t0.w, x2[2] * t1.x + x1[2] * t1.y, x2[3] * t1.z + x1[3] * t1.w};
}
DI pg8::f32x4 swap_lo(const pg8::f32x4& v) {
  pg8::f32x4 o;
#pragma unroll
  for (int k = 0; k < 4; ++k) { auto r = __builtin_amdgcn_permlane32_swap(__float_as_uint(v[k]), __float_as_uint(v[k]), false, false); o[k] = __uint_as_float(r[0]); }
  return o;
}
DI pg8::f32x4 swap_hi(const pg8::f32x4& v) {
  pg8::f32x4 o;
#pragma unroll
  for (int k = 0; k < 4; ++k) { auto r = __builtin_amdgcn_permlane32_swap(__float_as_uint(v[k]), __float_as_uint(v[k]), false, false); o[k] = __uint_as_float(r[1]); }
  return o;
}

struct EpiInproj {
  static constexpr bool PERM = true, AFTER_DRAIN = false;
  Params p; int S; bool atom;
  DI void operator()(const pg8::f32x4 (&acc)[2][2][4][2], const pg8::Unit& u, int wr, int wc, int fr_, int fq_) const {
    int fr = fr_, fq = fq_;
    asm volatile("" : "+v"(fr), "+v"(fq));
#pragma unroll
    for (int ai = 0; ai < 2; ++ai)
#pragma unroll
      for (int m = 0; m < 4; ++m) {
        const int tl = u.pm * 256 + ai * 128 + wr * 64 + m * 16 + fr;
        const int pos = tl & (S - 1);
        if (u.pn < 9) {
          const int which = u.pn / 3, head = (u.pn % 3) * 4 + wc;
          u16* dst = p.qkvb() + (size_t)tl * 2304 + which * 768 + head * 64 + 8 * fq;
          const pg8::f32x4 x1a = acc[ai][0][m][0], x1b = acc[ai][0][m][1], x2a = acc[ai][1][m][0], x2b = acc[ai][1][m][1];
          if (which < 2) {
            const float sc = (which == 0) ? QS_64 : 1.f;
            const float4* tab = (const float4*)(p.ropeB() + (size_t)pos * 32) + 4 * fq;
            const float4 t0 = tab[0], t1 = tab[1], t2 = tab[2], t3 = tab[3];
            st8(dst, rope_lo(x1a, x2a, t0, t1) * sc, rope_lo(x1b, x2b, t2, t3) * sc);
            st8(dst + 32, rope_hi(x1a, x2a, t0, t1) * sc, rope_hi(x1b, x2b, t2, t3) * sc);
          } else {
            st8(dst, x1a, x1b);
            st8(dst + 32, x2a, x2b);
          }
        } else {
#pragma unroll
          for (int bj = 0; bj < 2; ++bj) {
            const int c32 = u.pn * 256 + bj * 128 + wc * 32;
            const pg8::f32x4 a0 = acc[ai][bj][m][0], a1 = acc[ai][bj][m][1];
            if (c32 < SEC_MG) {
              const int i0 = c32 - SEC_QKVC;
              const float sc = (i0 < 512) ? QS_64 : 1.f;
              st8(p.qkvc() + (size_t)tl * 1536 + i0 + 8 * fq, a0 * sc, a1 * sc);
            } else if (c32 < SEC_GA) {
              st8(p.mg() + (size_t)tl * 3072 + (c32 - SEC_MG) + 8 * fq, sig4(a0), sig4(a1));
            } else if (c32 < SEC_CQ) {
              u16* dst;
              if (c32 < SEC_GB) dst = p.ga() + (size_t)tl * 512 + (c32 - SEC_GA);
              else if (c32 < SEC_GC) dst = p.gb() + (size_t)tl * 256 + (c32 - SEC_GB);
              else dst = p.gc() + (size_t)tl * 512 + (c32 - SEC_GC);
              st8(dst + 8 * fq, silu4(a0), silu4(a1));
            } else if (c32 < SEC_KR) {
              const bool isq = c32 < SEC_CKV;
              u16* dst = isq ? p.cq() + (size_t)tl * 384 + (c32 - SEC_CQ) : p.ckv() + (size_t)tl * 256 + (c32 - SEC_CKV);
              st8(dst + 8 * fq, a0, a1);
              float ss = a0[0] * a0[0] + a0[1] * a0[1] + a0[2] * a0[2] + a0[3] * a0[3] + a1[0] * a1[0] + a1[1] * a1[1] +
                         a1[2] * a1[2] + a1[3] * a1[3];
              ss += swz_xor<16>(ss);
              ss = half_add(ss);
              if (fq == 0 && atom) {
                if (isq) p.rowss_q()[(size_t)tl * 12 + ((c32 - SEC_CQ) >> 5)] = ss;
                else p.rowss_kv()[(size_t)tl * 8 + ((c32 - SEC_CKV) >> 5)] = ss;
              }
            } else if (c32 == SEC_KR) {
              const pg8::f32x4 x1a = swap_lo(a0), x1b = swap_lo(a1), x2a = swap_hi(a0), x2b = swap_hi(a1);
              const float4* tab = (const float4*)(p.ropeA() + (size_t)pos * 16) + 4 * (fq & 1);
              const float4 t0 = tab[0], t1 = tab[1], t2 = tab[2], t3 = tab[3];
              const bool lo = fq < 2;
              const pg8::f32x4 ya = lo ? rope_lo(x1a, x2a, t0, t1) : rope_hi(x1a, x2a, t0, t1);
              const pg8::f32x4 yb = lo ? rope_lo(x1b, x2b, t2, t3) : rope_hi(x1b, x2b, t2, t3);
              u16* dst = p.ka() + (size_t)tl * 768 + 64 + 8 * fq;
#pragma unroll
              for (int hd = 0; hd < 8; ++hd) st8(dst + hd * 96, ya, yb);
            }
          }
        }
      }
  }
};

template <bool ISQ>
struct EpiUp {
  static constexpr bool PERM = !ISQ, AFTER_DRAIN = false;
  Params p; int S;
  DI void operator()(const pg8::f32x4 (&acc)[2][2][4][2], const pg8::Unit& u, int wr, int wc, int fr_, int fq_) const {
    int fr = fr_, fq = fq_;
    asm volatile("" : "+v"(fr), "+v"(fq));
#pragma unroll
    for (int ai = 0; ai < 2; ++ai)
#pragma unroll
      for (int m = 0; m < 4; ++m) {
        const int tl = u.pm * 256 + ai * 128 + wr * 64 + m * 16 + fr;
        if (ISQ) {
          const float4* rq = (const float4*)(p.rowss_q() + (size_t)tl * 12);
          const float4 r0 = rq[0], r1 = rq[1], r2 = rq[2];
          const float ssq = ((((((((((r0.x + r0.y) + r0.z) + r0.w) + r1.x) + r1.y) + r1.z) + r1.w) + r2.x) + r2.y) + r2.z) + r2.w;
          const float sc = rsqrtf(ssq * (1.f / 384.f) + EPS) * QS_A;
          const int pos = tl & (S - 1);
#pragma unroll
          for (int bj = 0; bj < 2; ++bj) {
            const int c32 = u.pn * 256 + bj * 128 + wc * 32;
            const pg8::f32x4 a0 = acc[ai][bj][m][0], a1 = acc[ai][bj][m][1];
            u16* dst = p.qa() + (size_t)tl * 768 + c32 + 4 * fq;
            if ((c32 % 96) == 64) {
              const float4* tab = (const float4*)(p.ropeA() + (size_t)pos * 16);
              const float4 t0 = tab[2 * fq], t1 = tab[2 * fq + 1];
              st4(dst, (a0[0] * t0.x - a1[0] * t0.y) * sc, (a0[1] * t0.z - a1[1] * t0.w) * sc, (a0[2] * t1.x - a1[2] * t1.y) * sc,
                  (a0[3] * t1.z - a1[3] * t1.w) * sc);
              st4(dst + 16, (a1[0] * t0.x + a0[0] * t0.y) * sc, (a1[1] * t0.z + a0[1] * t0.w) * sc,
                  (a1[2] * t1.x + a0[2] * t1.y) * sc, (a1[3] * t1.z + a0[3] * t1.w) * sc);
            } else {
              st4v(dst, a0 * sc); st4v(dst + 16, a1 * sc);
            }
          }
        } else {
          const float4* rk = (const float4*)(p.rowss_kv() + (size_t)tl * 8);
          const float4 r0 = rk[0], r1 = rk[1];
          const float ssk = ((((((r0.x + r0.y) + r0.z) + r0.w) + r1.x) + r1.y) + r1.z) + r1.w;
          const float ri = rsqrtf(ssk * (1.f / 256.f) + EPS);
#pragma unroll
          for (int bj = 0; bj < 2; ++bj) {
            const int c32 = u.pn * 256 + bj * 128 + wc * 32;
            const int hd = c32 >> 7, e0 = c32 & 127;
            u16* dst = ((e0 < 64) ? p.ka() + (size_t)tl * 768 + hd * 96 + e0 : p.va() + (size_t)tl * 512 + hd * 64 + (e0 - 64)) + 8 * fq;
            st8(dst, acc[ai][bj][m][0] * ri, acc[ai][bj][m][1] * ri);
          }
        }
      }
  }
};

template <int BR>
struct EpiBranch {
  static constexpr bool PERM = true, AFTER_DRAIN = false;
  Params p;
  DI void operator()(const pg8::f32x4 (&acc)[2][2][4][2], const pg8::Unit& u, int wr, int wc, int fr_, int fq_) const {
    int fr = fr_, fq = fq_;
    asm volatile("" : "+v"(fr), "+v"(fq));
#pragma unroll
    for (int ai = 0; ai < 2; ++ai)
#pragma unroll
      for (int m = 0; m < 4; ++m) {
        const int tl = u.pm * 256 + ai * 128 + wr * 64 + m * 16 + fr;
#pragma unroll
        for (int bj = 0; bj < 2; ++bj) {
          const int c = u.pn * 256 + bj * 128 + wc * 32 + 8 * fq;
          const uint4 mv = *(const uint4*)(p.mg() + (size_t)tl * 3072 + BR * 1024 + c);
          pg8::f32x4 v0 = acc[ai][bj][m][0], v1 = acc[ai][bj][m][1];
          v0[0] *= bflo(mv.x); v0[1] *= bfhi(mv.x); v0[2] *= bflo(mv.y); v0[3] *= bfhi(mv.y);
          v1[0] *= bflo(mv.z); v1[1] *= bfhi(mv.z); v1[2] *= bflo(mv.w); v1[3] *= bfhi(mv.w);
          u16* mx = p.mixed() + (size_t)tl * 1024 + c;
          if (BR != 0) {
            const uint4 o = *(const uint4*)mx;
            v0[0] += bflo(o.x); v0[1] += bfhi(o.x); v0[2] += bflo(o.y); v0[3] += bfhi(o.y);
            v1[0] += bflo(o.z); v1[1] += bfhi(o.z); v1[2] += bflo(o.w); v1[3] += bfhi(o.w);
          }
          st8(mx, v0, v1);
        }
      }
  }
};

struct EpiOut {
  static constexpr bool PERM = true, AFTER_DRAIN = false;
  Params p;
  DI void operator()(const pg8::f32x4 (&acc)[2][2][4][2], const pg8::Unit& u, int wr, int wc, int fr_, int fq_) const {
    int fr = fr_, fq = fq_;
    asm volatile("" : "+v"(fr), "+v"(fq));
#pragma unroll
    for (int ai = 0; ai < 2; ++ai)
#pragma unroll
      for (int m = 0; m < 4; ++m) {
        const int tl = u.pm * 256 + ai * 128 + wr * 64 + m * 16 + fr;
#pragma unroll
        for (int bj = 0; bj < 2; ++bj)
          st8(p.outh() + (size_t)tl * 1024 + u.pn * 256 + bj * 128 + wc * 32 + 8 * fq, acc[ai][bj][m][0], acc[ai][bj][m][1]);
      }
  }
};

template <int NM, int NN>
struct FixedOrder {
  int G, c;
  DI bool next(int i, pg8::Unit& u) const {
    constexpr int nwg = NM * NN, q = nwg / 8, r = nwg % 8, nig = 8 * NN;
    const int L = i * G + c;
    if (L >= nwg) return false;
    const int xcd = L & 7, off = L >> 3;
    const int wgid = (xcd < r ? xcd * (q + 1) : r * (q + 1) + (xcd - r) * q) + off;
    const int gid = wgid / nig, rem = wgid % nig;
    u.pm = gid * 8 + (rem & 7);
    u.pn = rem >> 3;
    return true;
  }
  DI void a_ready(const pg8::Unit&) const {}
  DI void done(const pg8::Unit&) const {}
};

template <int N, int K, class Epi>
DI void run_gemm(char* smem, const u16* A, const u16* Bt, const Epi& E) {
  pg8::Gemm g{A, Bt, CT, N, K};
  FixedOrder<CT / 256, N / 256> so{(int)gridDim.x, (int)blockIdx.x};
  pg8::gemm_phase<Epi, FixedOrder<CT / 256, N / 256>, false>((PG8_LAS unsigned char*)smem, g, so, E, nullptr);
}

DI int inproj_orig_col(int np) {
  if (np < SEC_QKVC) {
    const int t = np >> 8, cc = np & 255, half = cc >> 7, hit = (cc >> 5) & 3;
    return 1184 + (t / 3) * 768 + ((t % 3) * 4 + hit) * 64 + half * 32;
  }
  if (np < SEC_MG) return 3744 + (np - SEC_QKVC);
  if (np < SEC_GA) return 5792 + (np - SEC_MG);
  if (np < SEC_GB) return 672 + (np - SEC_GA);
  if (np < SEC_GC) return 3488 + (np - SEC_GB);
  if (np < SEC_CQ) return 5280 + (np - SEC_GC);
  if (np < SEC_CKV) return 0 + (np - SEC_CQ);
  if (np < SEC_KR) return 384 + (np - SEC_CKV);
  if (np < SEC_KR + 32) return 640 + (np - SEC_KR);
  return -1;
}
DI void conv_tile(const float* __restrict__ src, int N, int ncol0, int k0, const float* __restrict__ kscale,
                  u16* __restrict__ dst, int K, int nrow0, float* tl, int tid) {
  __syncthreads();
  {
    const int kr = tid >> 3, n4 = (tid & 7) * 4;
#pragma unroll
    for (int i = 0; i < 2; ++i) {
      const int k = kr + 64 * i;
      float4 v = make_float4(0.f, 0.f, 0.f, 0.f);
      if (ncol0 >= 0) {
        v = *(const float4*)(src + (size_t)(k0 + k) * N + ncol0 + n4);
        if (kscale) { const float g = kscale[k0 + k]; v.x *= g; v.y *= g; v.z *= g; v.w *= g; }
      }
      tl[k * 33 + n4] = v.x; tl[k * 33 + n4 + 1] = v.y; tl[k * 33 + n4 + 2] = v.z; tl[k * 33 + n4 + 3] = v.w;
    }
  }
  __syncthreads();
  {
    const int n = tid >> 4, k8 = (tid & 15) * 8;
    uint4 o;
    o.x = pack2(tl[(k8 + 0) * 33 + n], tl[(k8 + 1) * 33 + n]);
    o.y = pack2(tl[(k8 + 2) * 33 + n], tl[(k8 + 3) * 33 + n]);
    o.z = pack2(tl[(k8 + 4) * 33 + n], tl[(k8 + 5) * 33 + n]);
    o.w = pack2(tl[(k8 + 6) * 33 + n], tl[(k8 + 7) * 33 + n]);
    *(uint4*)(dst + (size_t)(nrow0 + n) * K + k0 + k8) = o;
  }
}
constexpr int CONV_PER_LAYER = 2240 + 72 + 64 + 128 + 64 + 128 + 256;
constexpr int NCONV = CONV_PER_LAYER * DEPTH;
constexpr int NADA = DEPTH * 96;
constexpr int NROPE = 4096 * 48 / 512;

DI void phase_prep(const Params& p, char* smem) {
  const int tid = get_tid(p);
  float* fl = (float*)smem;
  for (int job = blockIdx.x; job < NCONV + NADA + NROPE; job += gridDim.x) {
    if (job < NCONV) {
      int l = job / CONV_PER_LAYER, j = job % CONV_PER_LAYER;
      if (j < 2240) {
        int nt = j >> 3, kt = j & 7;
        conv_tile(p.w_in + (size_t)l * DM * D_IN, D_IN, inproj_orig_col(nt * 32), kt * 128, nullptr,
                  p.wt_in() + (size_t)l * NIN * DM, DM, nt * 32, fl, tid);
      } else if ((j -= 2240) < 72) {
        int nt = j / 3, kt = j % 3;
        conv_tile(p.w_uq + (size_t)l * 384 * 768, 768, nt * 32, kt * 128, p.g_q + l * 384, p.wt_uq() + (size_t)l * 768 * 384,
                  384, nt * 32, fl, tid);
      } else if ((j -= 72) < 64) {
        int nt = j >> 1, kt = j & 1;
        conv_tile(p.w_ukv + (size_t)l * 256 * 1024, 1024, nt * 32, kt * 128, p.g_kv + l * 256,
                  p.wt_ukv() + (size_t)l * 1024 * 256, 256, nt * 32, fl, tid);
      } else if ((j -= 64) < 128) {
        int nt = j >> 2, kt = j & 3;
        conv_tile(p.w_pa + (size_t)l * 512 * 1024, 1024, nt * 32, kt * 128, nullptr, p.wt_pa() + (size_t)l * 1024 * 512, 512,
                  nt * 32, fl, tid);
      } else if ((j -= 128) < 64) {
        int nt = j >> 1, kt = j & 1;
        conv_tile(p.w_pb + (size_t)l * 256 * 1024, 1024, nt * 32, kt * 128, nullptr, p.wt_pb() + (size_t)l * 1024 * 256, 256,
                  nt * 32, fl, tid);
      } else if ((j -= 64) < 128) {
        int nt = j >> 2, kt = j & 3;
        conv_tile(p.w_pc + (size_t)l * 512 * 1024, 1024, nt * 32, kt * 128, nullptr, p.wt_pc() + (size_t)l * 1024 * 512, 512,
                  nt * 32, fl, tid);
      } else {
        j -= 128;
        int nt = j >> 3, kt = j & 7;
        conv_tile(p.w_out + (size_t)l * 1024 * 1024, 1024, nt * 32, kt * 128, nullptr, p.wt_out() + (size_t)l * 1024 * 1024,
                  1024, nt * 32, fl, tid);
      }
    } else if (job < NCONV + NADA) {
      int jb = job - NCONV;
      int l = jb / 96, j0 = (jb % 96) * 32;
      int jj = tid & 31, kp = tid >> 5;
      float* cs = fl;
      float* red = fl + 24 * 128;
      float acc[24];
#pragma unroll
      for (int b = 0; b < 24; ++b) acc[b] = 0.f;
      const float* W = p.w_ada + (size_t)l * DM * 3072 + j0 + jj;
      for (int ch = 0; ch < 8; ++ch) {
        __syncthreads();
        for (int e = tid; e < 24 * 128; e += 512) {
          int b = e >> 7, kk = e & 127;
          float cv = (b < 16) ? p.c_prompt[b * DM + ch * 128 + kk] : p.c_sample[(b - 16) * DM + ch * 128 + kk];
          cs[e] = siluf_(cv);
        }
        __syncthreads();
#pragma unroll 4
        for (int kk = kp * 8; kk < kp * 8 + 8; ++kk) {
          float w = W[(size_t)(ch * 128 + kk) * 3072];
#pragma unroll
          for (int b = 0; b < 24; ++b) acc[b] += cs[b * 128 + kk] * w;
        }
      }
      __syncthreads();
#pragma unroll
      for (int b = 0; b < 24; ++b) red[(kp * 24 + b) * 32 + jj] = acc[b];
      __syncthreads();
      for (int e = tid; e < 24 * 32; e += 512) {
        int b = e >> 5, j = e & 31;
        float s = 0.f;
#pragma unroll
        for (int q = 0; q < 16; ++q) s += red[(q * 24 + b) * 32 + j];
        p.mod()[((size_t)l * 24 + b) * 3072 + j0 + j] = s + p.b_ada[l * 3072 + j0 + j];
      }
    } else {
      int e = (job - NCONV - NADA) * 512 + tid;
      int pos = e / 48, f = e % 48;
      double base, inv = 1.0;
      int ex;
      if (f < 32) { base = 0.7498942093324559; ex = f; }
      else { base = 0.5623413251903491; ex = f - 32; }
      for (int i = 0; i < ex; ++i) inv *= base;
      double ang = (double)pos * inv;
      double n = rint(ang * 0.15915494309189535);
      float rr = (float)(ang - n * 6.283185307179586);
      float2 cs2 = make_float2(__cosf(rr), __sinf(rr));
      if (f < 32) p.ropeB()[pos * 32 + f] = cs2;
      else p.ropeA()[pos * 16 + (f - 32)] = cs2;
    }
  }
}

DI const float* x_row_in(const Params& p, int t) {
  return (t < NPTOK) ? p.x_prompt + (size_t)t * DM : p.x_sample + (size_t)(t - NPTOK) * DM;
}
DI void write_h(const Params& p, int l, int b, int tl, int lane, const float (&y)[16]) {
  float ss = 0.f;
#pragma unroll
  for (int i = 0; i < 16; ++i) ss += y[i] * y[i];
  ss = wave_sum(ss);
  float rinv = rsqrtf(ss * (1.f / DM) + EPS);
  const float* md = p.mod() + ((size_t)l * 24 + b) * 3072;
#pragma unroll
  for (int i = 0; i < 4; ++i) {
    int col = 4 * lane + 256 * i;
    float4 g = *(const float4*)(p.g_pre + l * DM + col);
    float4 sh = *(const float4*)(md + col);
    float4 sc = *(const float4*)(md + 1024 + col);
    st4(p.hbuf() + (size_t)tl * DM + col, y[4 * i + 0] * rinv * g.x * (1.f + sc.x) + sh.x,
        y[4 * i + 1] * rinv * g.y * (1.f + sc.y) + sh.y, y[4 * i + 2] * rinv * g.z * (1.f + sc.z) + sh.z,
        y[4 * i + 3] * rinv * g.w * (1.f + sc.w) + sh.w);
  }
}
DI void phase_norm0(const Params& p, int c, int S, int bbase) {
  const int tid_ = get_tid(p); const int lane = tid_ & 63, wv = tid_ >> 6;
  for (int tl = blockIdx.x * 8 + wv; tl < CT; tl += gridDim.x * 8) {
    const float* xr = x_row_in(p, c * CT + tl);
    float y[16];
#pragma unroll
    for (int i = 0; i < 4; ++i) {
      float4 v = *(const float4*)(xr + 4 * lane + 256 * i);
      y[4 * i] = v.x; y[4 * i + 1] = v.y; y[4 * i + 2] = v.z; y[4 * i + 3] = v.w;
    }
    write_h(p, 0, bbase + (tl >> (S == 2048 ? 11 : 12)), tl, lane, y);
  }
}
DI void phase_post(const Params& p, int c, int l, int S, int bbase) {
  const int tid_ = get_tid(p); const int lane = tid_ & 63, wv = tid_ >> 6;
  const int stride = gridDim.x * 8;
  for (int tl0 = blockIdx.x * 8 + wv; tl0 < CT; tl0 += 2 * stride) {
    const bool two = (tl0 + stride) < CT;
    const int tls[2] = {tl0, two ? tl0 + stride : tl0};
    float o[2][16], x[2][16], y[2][16];
    float ss[2] = {0.f, 0.f};
#pragma unroll
    for (int q = 0; q < 2; ++q) {
      const int tl = tls[q], t = c * CT + tl;
      const u16* orow = p.outh() + (size_t)tl * DM;
      const float* xr = (l == 0) ? x_row_in(p, t) : p.out + (size_t)t * DM;
#pragma unroll
      for (int i = 0; i < 4; ++i) {
        const uint2 v = *(const uint2*)(orow + 4 * lane + 256 * i);
        const float4 xv = *(const float4*)(xr + 4 * lane + 256 * i);
        o[q][4 * i] = bflo(v.x); o[q][4 * i + 1] = bfhi(v.x); o[q][4 * i + 2] = bflo(v.y); o[q][4 * i + 3] = bfhi(v.y);
        x[q][4 * i] = xv.x; x[q][4 * i + 1] = xv.y; x[q][4 * i + 2] = xv.z; x[q][4 * i + 3] = xv.w;
      }
    }
#pragma unroll
    for (int q = 0; q < 2; ++q) {
#pragma unroll
      for (int i = 0; i < 16; ++i) ss[q] += o[q][i] * o[q][i];
      ss[q] = wave_sum(ss[q]);
    }
#pragma unroll
    for (int q = 0; q < 2; ++q) {
      if (q == 1 && !two) break;
      const int tl = tls[q], t = c * CT + tl, b = bbase + (tl >> (S == 2048 ? 11 : 12));
      const float rinv = rsqrtf(ss[q] * (1.f / DM) + EPS);
      const float* md = p.mod() + ((size_t)l * 24 + b) * 3072 + 2048;
#pragma unroll
      for (int i = 0; i < 4; ++i) {
        int col = 4 * lane + 256 * i;
        float4 g = *(const float4*)(p.g_post + l * DM + col);
        float4 gt = *(const float4*)(md + col);
        float4 yv;
        yv.x = x[q][4 * i] + gt.x * (o[q][4 * i] * rinv * g.x);
        yv.y = x[q][4 * i + 1] + gt.y * (o[q][4 * i + 1] * rinv * g.y);
        yv.z = x[q][4 * i + 2] + gt.z * (o[q][4 * i + 2] * rinv * g.z);
        yv.w = x[q][4 * i + 3] + gt.w * (o[q][4 * i + 3] * rinv * g.w);
        *(float4*)(p.out + (size_t)t * DM + col) = yv;
        y[q][4 * i] = yv.x; y[q][4 * i + 1] = yv.y; y[q][4 * i + 2] = yv.z; y[q][4 * i + 3] = yv.w;
      }
      if (l + 1 < DEPTH) write_h(p, l + 1, b, tl, lane, y[q]);
    }
  }
}

struct HalfBar {
  volatile LDSP unsigned* cnt;
  unsigned target;
};
DI void half_sync(HalfBar& hb, int lane) {
  asm volatile("s_waitcnt vmcnt(0) lgkmcnt(0)" ::: "memory");
  hb.target += 4u;
  if (lane == 0) {
    __hip_atomic_fetch_add((LDSP unsigned*)hb.cnt, 1u, __ATOMIC_RELAXED, __HIP_MEMORY_SCOPE_WORKGROUP);
    while (__hip_atomic_load((LDSP unsigned*)hb.cnt, __ATOMIC_RELAXED, __HIP_MEMORY_SCOPE_WORKGROUP) < hb.target) __builtin_amdgcn_s_sleep(1);
  }
  asm volatile("s_waitcnt lgkmcnt(0)" ::: "memory");
}

constexpr int VSTR = 72;
constexpr int ATT_LDS = 128 * 104 * 2 + 128 * VSTR * 2 + 2048;
template <int MODE>
DI void attn_item(const Params& p, int item, int l, int lgS, char* smem, char* smem0, HalfBar& hb, bool dry = false) {
  const int S = 1 << lgS, lgq = lgS - 7;
  constexpr int DQK = (MODE == 0) ? 96 : 64;
  constexpr int KSTR = DQK + 8;
  constexpr int NKS = DQK / 16;
  constexpr int KCH = DQK / 8;
  constexpr int NKL = KCH * 64 / 256;
  constexpr bool SHARED = (MODE != 1);
  char* tbase = SHARED ? smem0 : smem;
  u16* Ks = (u16*)tbase;
  u16* Vs = (u16*)(tbase + 128 * 104 * 2);
  float* bias = (float*)(smem + 128 * 104 * 2 + 128 * VSTR * 2);
  const int tidS = get_tid(p);
  const int tid = tidS & 255, lane = tid & 63, w = tid >> 6, r = lane & 31, h = lane >> 5;

  int tb, nkt;
  const u16 *Qp, *Kb, *Vb;
  int kld, vld;
  int tlq;
  int dd = 1, L = 0, rc = 0, qb = 0, grp = 0, hj = 0;
  int rows = 0, rsU = 0, rsL = 0, rsT = 0, k0 = 0, qr = 0, qc = 0, rsq = 0, csq = 0, hd = 0;
  if constexpr (MODE == 0) {
    const int s = item >> (lgq + 3), rem = item & ((8 << lgq) - 1);
    hd = rem >> lgq;
    const int qblk = rem & ((1 << lgq) - 1);
    tb = s << lgS;
    tlq = tb + qblk * 128 + 32 * w + r;
    Qp = p.qa() + (size_t)tlq * 768 + hd * 96;
    Kb = p.ka() + hd * 96; kld = 768;
    Vb = p.va() + hd * 64; vld = 512;
    nkt = S >> 6;
  } else if constexpr (MODE == 1) {
    const int blk = item >> lgq, cb = item & ((1 << lgq) - 1);
    const int s = blk / 12, hh = blk % 12;
    grp = hh >> 2; hj = hh & 3;
    const int lgd = 2 * grp;
    dd = 1 << lgd;
    L = S >> lgd;
    const int lgn = lgq - lgd;
    rc = cb >> lgn; qb = cb & ((1 << lgn) - 1);
    tb = s << lgS;
    tlq = tb + rc + dd * (qb * 128 + 32 * w + r);
    Qp = p.qkvb() + (size_t)tlq * 2304 + hh * 64;
    Kb = p.qkvb() + 768 + hh * 64; kld = 2304;
    Vb = p.qkvb() + 1536 + hh * 64; vld = 2304;
    nkt = 4;
  } else {
    rows = S >> 6;
    const int s = item >> (lgq + 3), rem = item & ((8 << lgq) - 1);
    hd = rem >> lgq;
    const int R = rem & ((1 << lgq) - 1);
    tb = s << lgS;
    qr = 2 * R + (r >> 4); qc = 16 * w + (r & 15);
    tlq = tb + qr * 64 + qc;
    k0 = (w == 0) ? 0 : (w == 1 ? 8 : (w == 2 ? 24 : 32));
    rsU = min(max(2 * (R & ~1) - 4, 0), rows - 8);
    rsL = min(max(2 * R - 4, 0), rows - 8);
    rsT = min(max(2 * R + 1 - 4, 0), rows - 8) + 8;
    rsq = min(max(qr - 4, 0), rows - 8);
    csq = min(max(qc - 8, 0), 48);
    Qp = p.qkvc() + (size_t)tlq * 1536 + hd * 64;
    Kb = p.qkvc() + 512 + hd * 64; kld = 1536;
    Vb = p.qkvc() + 1024 + hd * 64; vld = 1536;
    nkt = 12;
  }

  __syncthreads();
  if constexpr (MODE == 2) {
    const float* bsrc = p.rpb + ((size_t)l * 8 + hd) * 465;
    for (int e = tid; e < 465; e += 256) bias[e] = bsrc[e] * LOG2E;
  }

  bf16x8 qf[NKS];
#pragma unroll
  for (int ks = 0; ks < NKS; ++ks) qf[ks] = *(const bf16x8*)(Qp + 16 * ks + 8 * h);

  u32x4 kreg[2 * NKL], vreg[4];
  auto key_tok = [&](int kt, int kk) -> int {
    if constexpr (MODE == 0) return tb + kt * 64 + kk;
    else if constexpr (MODE == 1) {
      int km = qb * 128 - 64 + kt * 64 + kk;
      km = min(max(km, 0), L - 1);
      return tb + rc + dd * km;
    } else {
      int krow = min(rsU + kt, rows - 1);
      return tb + krow * 64 + kk;
    }
  };
  unsigned koff[3], voff[2];
#pragma unroll
  for (int i = 0; i < 3; ++i) { const int id = tidS + 512 * i; koff[i] = (unsigned)((id / 12) * 768 + (id % 12) * 8); }
#pragma unroll
  for (int i = 0; i < 2; ++i) { const int id = tidS + 512 * i; voff[i] = (unsigned)((id >> 3) * 512 + (id & 7) * 8); }
  auto load_tile = [&](int kt2) {
    if constexpr (MODE == 0) {
      const u16* Kt = Kb + (size_t)(tb + kt2 * 128) * 768;
      const u16* Vt = Vb + (size_t)(tb + kt2 * 128) * 512;
#pragma unroll
      for (int i = 0; i < 3; ++i) kreg[i] = *(const u32x4*)(Kt + koff[i]);
#pragma unroll
      for (int i = 0; i < 2; ++i) vreg[i] = *(const u32x4*)(Vt + voff[i]);
      return;
    }
    if constexpr (MODE == 2) {
#pragma unroll
      for (int i = 0; i < 2; ++i) {
        const int id = tidS + 512 * i, k2 = id >> 3, cc = id & 7;
        const unsigned to = (unsigned)key_tok(2 * kt2 + (k2 >> 6), k2 & 63);
        kreg[i] = *(const u32x4*)(Kb + (to * (unsigned)kld + cc * 8));
        vreg[i] = *(const u32x4*)(Vb + (to * (unsigned)vld + cc * 8));
      }
      return;
    }
#pragma unroll
    for (int sub = 0; sub < 2; ++sub) {
      if constexpr (MODE == 0) {
      } else {
#pragma unroll
        for (int i = 0; i < NKL; ++i) {
          int id = tid + 256 * i;
          int kk = id / KCH, cc = id % KCH;
          kreg[sub * NKL + i] = *(const u32x4*)(Kb + (unsigned)(key_tok(2 * kt2 + sub, kk) * kld + cc * 8));
        }
#pragma unroll
        for (int i = 0; i < 2; ++i) {
          int id = tid + 256 * i;
          int kk = id >> 3, cc = id & 7;
          vreg[sub * 2 + i] = *(const u32x4*)(Vb + (unsigned)(key_tok(2 * kt2 + sub, kk) * vld + cc * 8));
        }
      }
    }
  };
  auto store_tile = [&]() {
    if constexpr (MODE == 0) {
#pragma unroll
      for (int i = 0; i < 3; ++i) { const int id = tidS + 512 * i; *(u32x4*)(Ks + (id / 12) * KSTR + (id % 12) * 8) = kreg[i]; }
#pragma unroll
      for (int i = 0; i < 2; ++i) { const int id = tidS + 512 * i; *(u32x4*)(Vs + (id >> 3) * VSTR + (id & 7) * 8) = vreg[i]; }
      return;
    }
    if constexpr (MODE == 2) {
#pragma unroll
      for (int i = 0; i < 2; ++i) {
        const int id = tidS + 512 * i, k2 = id >> 3, cc = id & 7;
        *(u32x4*)(Ks + k2 * KSTR + cc * 8) = kreg[i];
        *(u32x4*)(Vs + k2 * VSTR + cc * 8) = vreg[i];
      }
      return;
    }
#pragma unroll
    for (int sub = 0; sub < 2; ++sub) {
#pragma unroll
      for (int i = 0; i < NKL; ++i) {
        int id = tid + 256 * i;
        int kk = id / KCH, cc = id % KCH;
        *(u32x4*)(Ks + (64 * sub + kk) * KSTR + cc * 8) = kreg[sub * NKL + i];
      }
#pragma unroll
      for (int i = 0; i < 2; ++i) {
        int id = tid + 256 * i;
        int kk = id >> 3, cc = id & 7;
        *(u32x4*)(Vs + (64 * sub + kk) * VSTR + cc * 8) = vreg[sub * 2 + i];
      }
    }
  };

  f32x16 O[2];
#pragma unroll
  for (int i = 0; i < 16; ++i) { O[0][i] = 0.f; O[1][i] = 0.f; }
  float m = 0.f, lsum = 0.f;
  const int i16 = lane & 15, tq = i16 >> 2, tp = i16 & 3, tu = (lane >> 4) & 1;
  const u16* vtr = Vs + (4 * h + tq) * VSTR + 16 * tu + 4 * tp;

  const int nkt2 = (nkt + 1) >> 1;
  load_tile(0);
  for (int kt2 = 0; kt2 < nkt2; ++kt2) {
    __syncthreads();
    store_tile();
    __syncthreads();
#if PROBE_REP == 7
    if (kt2 + 1 < nkt2 && !dry) load_tile(kt2 + 1);
#else
    if (kt2 + 1 < nkt2) load_tile(kt2 + 1);
#endif
#pragma unroll
   for (int sub = 0; sub < 2; ++sub) {
    const int kt = 2 * kt2 + sub;
    bool use = true;
    int kmb = 0;
    if constexpr (MODE == 1) {
      kmb = qb * 128 - 64 + kt * 64;
      const int qw = qb * 128 + 32 * w;
      use = !(kmb > qw + 95 || kmb + 63 < qw - 64 || kmb + 63 < 0 || kmb >= L);
    } else if constexpr (MODE == 2) {
      use = ((rsU + kt) >= rsL) && ((rsU + kt) < rsT);
    }
    if (use) {
      constexpr int NKG = (MODE == 2) ? 1 : 2;
      const int kofs = (MODE == 2) ? k0 : 0;
      f32x16 sacc[NKG];
      {
        const float negm = -m;
#pragma unroll
        for (int kg = 0; kg < NKG; ++kg) {
#pragma unroll
          for (int i = 0; i < 16; ++i) sacc[kg][i] = negm;
#pragma unroll
          for (int ks = 0; ks < NKS; ++ks) {
            bf16x8 kf = *(const bf16x8*)(Ks + (64 * sub + kofs + 32 * kg + r) * KSTR + 16 * ks + 8 * h);
            sacc[kg] = mfma(kf, qf[ks], sacc[kg]);
          }
        }
      }
      if constexpr (MODE == 1) {
        const int qm = qb * 128 + 32 * w + r;
#pragma unroll
        for (int kg = 0; kg < 2; ++kg)
#pragma unroll
          for (int i = 0; i < 16; ++i) {
            const int km = kmb + 32 * kg + crow(i, h);
            const int df = km - qm;
            const bool ok = (km >= 0) && (km < L) && (df <= 64) && (df >= -64);
            sacc[kg][i] = ok ? sacc[kg][i] : NEGBIG;
          }
      } else if constexpr (MODE == 2) {
        const int krow = rsU + kt;
        const bool rowok = (krow >= rsq) && (krow < rsq + 8);
        const float* brow = bias + min(max(krow - qr + 7, 0), 14) * 31;
#pragma unroll
        for (int i = 0; i < 16; ++i) {
          const int kc = k0 + crow(i, h);
          const bool ok = rowok && (kc >= csq) && (kc < csq + 16);
          const int co = min(max(kc - qc + 15, 0), 30);
          sacc[0][i] = ok ? sacc[0][i] + brow[co] : NEGBIG;
        }
      }
      float mx = sacc[0][0];
#pragma unroll
      for (int kg = 0; kg < NKG; ++kg)
#pragma unroll
        for (int i = 0; i < 16; ++i) mx = fmaxf(mx, sacc[kg][i]);
      mx = half_max(mx);
      if (__any(mx > 6.0f)) {
        const float off = fmaxf(mx, 0.f);
        const float alpha = __builtin_amdgcn_exp2f(-off);
        m += off;
        lsum *= alpha;
#pragma unroll
        for (int kg = 0; kg < NKG; ++kg)
#pragma unroll
          for (int i = 0; i < 16; ++i) sacc[kg][i] -= off;
#pragma unroll
        for (int i = 0; i < 16; ++i) { O[0][i] *= alpha; O[1][i] *= alpha; }
      }
      float ps = 0.f;
#pragma unroll
      for (int kg = 0; kg < NKG; ++kg)
#pragma unroll
        for (int i = 0; i < 16; ++i) {
          float pv = __builtin_amdgcn_exp2f(sacc[kg][i]);
          sacc[kg][i] = pv;
          ps += pv;
        }
      lsum += ps;
#pragma unroll
      for (int kg = 0; kg < NKG; ++kg)
#pragma unroll
        for (int s2 = 0; s2 < 2; ++s2) {
          uint4 pk;
          pk.x = pack2(sacc[kg][8 * s2 + 0], sacc[kg][8 * s2 + 1]);
          pk.y = pack2(sacc[kg][8 * s2 + 2], sacc[kg][8 * s2 + 3]);
          pk.z = pack2(sacc[kg][8 * s2 + 4], sacc[kg][8 * s2 + 5]);
          pk.w = pack2(sacc[kg][8 * s2 + 6], sacc[kg][8 * s2 + 7]);
          const bf16x8 pf = __builtin_bit_cast(bf16x8, pk);
#pragma unroll
          for (int dt = 0; dt < 2; ++dt) {
            const u16* va = vtr + (64 * sub + kofs + 32 * kg + 16 * s2) * VSTR + 32 * dt;
            s16x4 lo = __builtin_amdgcn_ds_read_tr16_b64_v4i16((LDSP s16x4*)(va));
            s16x4 hi = __builtin_amdgcn_ds_read_tr16_b64_v4i16((LDSP s16x4*)(va + 8 * VSTR));
            bf16x8 vf = __builtin_shufflevector(lo, hi, 0, 1, 2, 3, 4, 5, 6, 7);
            O[dt] = mfma(vf, pf, O[dt]);
          }
        }
    }
   }
  }
  const float ltot = half_add(lsum);
  const float inv = ltot > 0.f ? 1.f / ltot : 0.f;
  if (dry && inv != 12345.678f) return;
  u16* base;
  if constexpr (MODE == 1) base = p.ob() + ((size_t)grp * CT + tlq) * 256 + hj * 64;
  else if constexpr (MODE == 0) base = p.ga() + (size_t)tlq * 512 + hd * 64;
  else base = p.gc() + (size_t)tlq * 512 + hd * 64;
#pragma unroll
  for (int dt = 0; dt < 2; ++dt)
#pragma unroll
    for (int k = 0; k < 2; ++k) {
      float lo4[4], hi4[4];
#pragma unroll
      for (int jj = 0; jj < 4; ++jj) {
        auto rr = __builtin_amdgcn_permlane32_swap(__float_as_uint(O[dt][8 * k + jj]), __float_as_uint(O[dt][8 * k + 4 + jj]), false, false);
        lo4[jj] = __uint_as_float(rr[0]) * inv;
        hi4[jj] = __uint_as_float(rr[1]) * inv;
      }
      u16* a = base + 32 * dt + 16 * k + 8 * h;
      u32x4 o;
      if constexpr (MODE == 1) {
        o[0] = pack2(lo4[0], lo4[1]); o[1] = pack2(lo4[2], lo4[3]); o[2] = pack2(hi4[0], hi4[1]); o[3] = pack2(hi4[2], hi4[3]);
      } else {
        const u32x4 gv = *(const u32x4*)a;
        o[0] = pack2(lo4[0] * bflo(gv[0]), lo4[1] * bfhi(gv[0]));
        o[1] = pack2(lo4[2] * bflo(gv[1]), lo4[3] * bfhi(gv[1]));
        o[2] = pack2(hi4[0] * bflo(gv[2]), hi4[1] * bfhi(gv[2]));
        o[3] = pack2(hi4[2] * bflo(gv[3]), hi4[3] * bfhi(gv[3]));
      }
      *(u32x4*)a = o;
    }
  if constexpr (MODE == 1) {
    if (h == 0) p.lseb()[((size_t)grp * CT + tlq) * 4 + hj] = m + __log2f(ltot);
  }
}
#ifndef PROBE_REP
#define PROBE_REP 0
#endif
DI void phase_attn(const Params& p, int l, int lgS, char* smem, int which = 7, bool dry = false) {
  constexpr int N_MLA = (CT / 128) * 8;
  constexpr int N_NA = (CT / 128) * 8;
  constexpr int N_DIL = (CT / 128) * 12;
  const int half = __builtin_amdgcn_readfirstlane(get_tid(p) >> 8);
  char* sm = smem + half * ATT_LDS;
  HalfBar hb;
  hb.cnt = (volatile LDSP unsigned*)(sm + ATT_LDS - 16);
  hb.target = 0u;
  __syncthreads();
  if ((get_tid(p) & 255) == 0) *hb.cnt = 0u;
  __syncthreads();
  if (gridDim.x == 256) {
    const int lgq = lgS - 7, cpr = 64 >> lgq;
    const int xcd = blockIdx.x & 7, slot = (blockIdx.x >> 3) * 2 + half;
    const int sub = slot & ((1 << lgq) - 1), cl = slot >> lgq;
#pragma unroll 1
    for (int ri = 0; ri < 7; ++ri) {
      const int rd = ri;
      const int kind = (rd < 2) ? 0 : (rd < 4 ? 2 : 1);
      const int rr = (rd < 2) ? rd : (rd < 4 ? rd - 2 : rd - 4);
      const int it = (((rr * 8 + xcd) * cpr + cl) << lgq) + sub;
      if (kind == 0) { if (which & 1) attn_item<0>(p, it, l, lgS, sm, smem, hb, dry); }
      else if (kind == 2) { if (which & 2) attn_item<2>(p, it, l, lgS, sm, smem, hb, dry); }
      else { if (which & 4) attn_item<1>(p, it, l, lgS, sm, smem, hb, dry); }
    }
  } else {
    for (int pr = blockIdx.x; pr < (N_MLA + N_NA + N_DIL) / 2; pr += gridDim.x) {
      const int it = 2 * pr + half;
      if (it < N_MLA) { if (which & 1) attn_item<0>(p, it, l, lgS, sm, smem, hb, dry); }
      else if (it < N_MLA + N_NA) { if (which & 2) attn_item<2>(p, it - N_MLA, l, lgS, sm, smem, hb, dry); }
      else { if (which & 4) attn_item<1>(p, it - N_MLA - N_NA, l, lgS, sm, smem, hb, dry); }
    }
  }
  __syncthreads();
}

DI void phase_dilcomb(const Params& p) {
  const int tid_ = get_tid(p);
  for (int e = blockIdx.x * 512 + tid_; e < CT * 32; e += gridDim.x * 512) {
    const int tl = e >> 5, j = (e >> 3) & 3, ch = e & 7;
    float l0 = p.lseb()[((size_t)0 * CT + tl) * 4 + j], l1 = p.lseb()[((size_t)1 * CT + tl) * 4 + j],
          l2 = p.lseb()[((size_t)2 * CT + tl) * 4 + j];
    float mx = fmaxf(l0, fmaxf(l1, l2));
    float w0 = __builtin_amdgcn_exp2f(l0 - mx), w1 = __builtin_amdgcn_exp2f(l1 - mx), w2 = __builtin_amdgcn_exp2f(l2 - mx);
    float iw = 1.f / (w0 + w1 + w2);
    w0 *= iw; w1 *= iw; w2 *= iw;
    const size_t off = (size_t)tl * 256 + j * 64 + ch * 8;
    uint4 a = *(const uint4*)(p.ob() + off), b = *(const uint4*)(p.ob() + (size_t)CT * 256 + off),
          c = *(const uint4*)(p.ob() + (size_t)2 * CT * 256 + off);
    uint4 gv = *(const uint4*)(p.gb() + off);
    uint4 o;
    o.x = pack2((w0 * bflo(a.x) + w1 * bflo(b.x) + w2 * bflo(c.x)) * bflo(gv.x),
                (w0 * bfhi(a.x) + w1 * bfhi(b.x) + w2 * bfhi(c.x)) * bfhi(gv.x));
    o.y = pack2((w0 * bflo(a.y) + w1 * bflo(b.y) + w2 * bflo(c.y)) * bflo(gv.y),
                (w0 * bfhi(a.y) + w1 * bfhi(b.y) + w2 * bfhi(c.y)) * bfhi(gv.y));
    o.z = pack2((w0 * bflo(a.z) + w1 * bflo(b.z) + w2 * bflo(c.z)) * bflo(gv.z),
                (w0 * bfhi(a.z) + w1 * bfhi(b.z) + w2 * bfhi(c.z)) * bfhi(gv.z));
    o.w = pack2((w0 * bflo(a.w) + w1 * bflo(b.w) + w2 * bflo(c.w)) * bflo(gv.w),
                (w0 * bfhi(a.w) + w1 * bfhi(b.w) + w2 * bfhi(c.w)) * bfhi(gv.w));
    *(uint4*)(p.gb() + off) = o;
  }
}

#define XB_TMO      128
#define XB_XCNT(j)  (256  + 64 * (j))
#define XB_XSUB(j)  (1280 + 64 * (j))
#define XB_XGEN(j)  (2304 + 64 * (j))
#define XB_TOP      3328
#define XB_TOPGEN   3392
#define XCD_BAR_WORDS 3456
#define XB_SPIN_CAP (1u << 18)
#define LAS __attribute__((address_space(3)))

__device__ __forceinline__ unsigned xb_ld(unsigned* p)              { return __hip_atomic_load(p, __ATOMIC_RELAXED, __HIP_MEMORY_SCOPE_AGENT); }
__device__ __forceinline__ unsigned xb_add(unsigned* p, unsigned v) { return __hip_atomic_fetch_add(p, v, __ATOMIC_RELAXED, __HIP_MEMORY_SCOPE_AGENT); }
__device__ __forceinline__ unsigned xb_xcc_id() { return (unsigned)__builtin_amdgcn_s_getreg((3 << 11) | 20) & 0xFu; }
#define XB_SPIN(cond, bar) do { unsigned _sp = 0; while (cond) { __builtin_amdgcn_s_sleep(1); \
    if ((++_sp & 255u) == 0u) { if (xb_ld(&(bar)[XB_TMO])) break; if (_sp > XB_SPIN_CAP) { atomicAdd(&(bar)[XB_TMO], 1u); break; } } } } while (0)

struct XcdBarrier {
    int wv;
    unsigned* bar; unsigned x;
    volatile LAS unsigned* st;
};

__device__ __forceinline__ XcdBarrier xcd_barrier_post(unsigned* bar, volatile LAS unsigned* st, int wv) {
    XcdBarrier b; b.wv = wv; b.bar = bar; b.x = xb_xcc_id(); b.st = st;
    if (tid_from_wave(b.wv) == 0) (void)xb_add(&bar[XB_XCNT(b.x)], 1u);
    return b;
}
__device__ __forceinline__ void xcd_barrier_complete(unsigned* bar, unsigned x, unsigned& nloc, unsigned& nx) {
    const unsigned G = gridDim.x * gridDim.y * gridDim.z;
    unsigned sum, cnt, mine, sp = 0u;
    for (;;) {
        sum = 0u; cnt = 0u; mine = 0u;
#pragma unroll
        for (unsigned j = 0; j < 16; ++j) { const unsigned c = xb_ld(&bar[XB_XCNT(j)]); sum += c; cnt += (c > 0u) ? 1u : 0u; mine = (j == x) ? c : mine; }
        if (sum == G) break;
        __builtin_amdgcn_s_sleep(1);
        if ((++sp & 255u) == 0u) { if (xb_ld(&bar[XB_TMO])) break; if (sp > XB_SPIN_CAP) { atomicAdd(&bar[XB_TMO], 1u); break; } }
    }
    nloc = mine > 0u ? mine : 1u; nx = cnt > 0u ? cnt : 1u;
}

__device__ __forceinline__ void xcd_barrier(const XcdBarrier& b) {
    asm volatile("s_waitcnt vmcnt(0)" ::: "memory");
    __syncthreads();
    if (tid_from_wave(b.wv) == 0) {
        unsigned* bar = b.bar;
        __builtin_amdgcn_s_waitcnt(0);
        unsigned nloc = b.st[0], nx = b.st[1];
        if (nloc == 0u) { xcd_barrier_complete(bar, b.x, nloc, nx); b.st[0] = nloc; b.st[1] = nx; }
        const unsigned old = xb_add(&bar[XB_XSUB(b.x)], 1u);
        const unsigned gen = old / nloc;
        if (old + 1u == (gen + 1u) * nloc) {
            __builtin_amdgcn_fence(__ATOMIC_RELEASE, "agent");
            asm volatile("s_waitcnt vmcnt(0)" ::: "memory");
            const unsigned og = xb_add(&bar[XB_TOP], 1u);
            const unsigned tg = og / nx;
            if (og + 1u == (tg + 1u) * nx) xb_add(&bar[XB_TOPGEN], 1u);
            else XB_SPIN(xb_ld(&bar[XB_TOPGEN]) == tg, bar);
            __builtin_amdgcn_fence(__ATOMIC_ACQUIRE, "agent");
            xb_add(&bar[XB_XGEN(b.x)], 1u);
            asm volatile("s_waitcnt vmcnt(0)" ::: "memory");
        } else {
            XB_SPIN(xb_ld(&bar[XB_XGEN(b.x)]) == gen, bar);
            __builtin_amdgcn_fence(__ATOMIC_ACQUIRE, "agent");
            asm volatile("s_waitcnt vmcnt(0)" ::: "memory");
        }
    }
    __syncthreads();
}


constexpr int SMEM_STAGE = pg8::STAGE_BYTES;
constexpr int SMEM_BYTES = SMEM_STAGE + 16;
#ifndef PROBE_REP
#define PROBE_REP 0
#endif
__global__ void __launch_bounds__(512, 2) mega_kernel(Params pk) {
  cg::grid_group grid = cg::this_grid();
  Params p = pk;
  {
    int w = __builtin_amdgcn_readfirstlane((int)threadIdx.x >> 6);
    asm volatile("" : "+s"(w));
    p.wv = w;
  }
  extern __shared__ __attribute__((aligned(16))) char smem[];
  volatile LAS unsigned* xst = (volatile LAS unsigned*)(smem + SMEM_STAGE);
  if (threadIdx.x < 4) xst[threadIdx.x] = 0u;
  __syncthreads();
  const XcdBarrier xb = xcd_barrier_post((unsigned*)(p.ws + OFF_BAR), xst, p.wv);
  phase_prep(p, smem);
  grid.sync();
#pragma unroll 1
  for (int c = 0; c < NCHUNK; ++c) {
    const int S = (c < 2) ? 2048 : 4096;
    const int bbase = (c < 2) ? c * 8 : 16 + (c - 2) * 4;
    phase_norm0(p, c, S, bbase);
    xcd_barrier(xb);
#pragma unroll 1
    for (int l = 0; l < DEPTH; ++l) {
      run_gemm<NIN, DM>(smem, p.hbuf(), p.wt_in() + (size_t)l * NIN * DM, EpiInproj{p, S, true});
      xcd_barrier(xb);
#if PROBE_REP == 1
      run_gemm<NIN, DM>(smem, p.hbuf(), p.wt_in() + (size_t)l * NIN * DM, EpiInproj{p, S, false});
      xcd_barrier(xb);
#endif
      run_gemm<768, 384>(smem, p.cq(), p.wt_uq() + (size_t)l * 768 * 384, EpiUp<true>{p, S});
      run_gemm<1024, 256>(smem, p.ckv(), p.wt_ukv() + (size_t)l * 1024 * 256, EpiUp<false>{p, S});
      phase_attn(p, l, (c < 2) ? 11 : 12, smem, 6);
      xcd_barrier(xb);
#if PROBE_REP == 2 || PROBE_REP == 7
      phase_attn(p, l, (c < 2) ? 11 : 12, smem, 1, true);
      xcd_barrier(xb);
#elif PROBE_REP == 3
      phase_attn(p, l, (c < 2) ? 11 : 12, smem, 6, true);
      xcd_barrier(xb);
#elif PROBE_REP == 4
      run_gemm<768, 384>(smem, p.cq(), p.wt_uq() + (size_t)l * 768 * 384, EpiUp<true>{p, S});
      run_gemm<1024, 256>(smem, p.ckv(), p.wt_ukv() + (size_t)l * 1024 * 256, EpiUp<false>{p, S});
      xcd_barrier(xb);
#endif
      phase_attn(p, l, (c < 2) ? 11 : 12, smem, 1);
      phase_dilcomb(p);
      xcd_barrier(xb);
      run_gemm<1024, 512>(smem, p.ga(), p.wt_pa() + (size_t)l * 1024 * 512, EpiBranch<0>{p});
      run_gemm<1024, 256>(smem, p.gb(), p.wt_pb() + (size_t)l * 1024 * 256, EpiBranch<1>{p});
      run_gemm<1024, 512>(smem, p.gc(), p.wt_pc() + (size_t)l * 1024 * 512, EpiBranch<2>{p});
      xcd_barrier(xb);
      run_gemm<1024, 1024>(smem, p.mixed(), p.wt_out() + (size_t)l * 1024 * 1024, EpiOut{p});
      xcd_barrier(xb);
#if PROBE_REP == 5
      run_gemm<1024, 512>(smem, p.ga(), p.wt_pa() + (size_t)l * 1024 * 512, EpiBranch<0>{p});
      run_gemm<1024, 256>(smem, p.gb(), p.wt_pb() + (size_t)l * 1024 * 256, EpiBranch<1>{p});
      run_gemm<1024, 512>(smem, p.gc(), p.wt_pc() + (size_t)l * 1024 * 512, EpiBranch<2>{p});
      xcd_barrier(xb);
      run_gemm<1024, 1024>(smem, p.mixed(), p.wt_out() + (size_t)l * 1024 * 1024, EpiOut{p});
      xcd_barrier(xb);
#endif
      phase_post(p, c, l, S, bbase);
      xcd_barrier(xb);
#if PROBE_REP == 6
#pragma unroll 1
      for (int q = 0; q < 10; ++q) xcd_barrier(xb);
#endif
    }
  }
}

extern "C" void kernel_launch(void* const* d_in, const int* in_sizes, int n_in, void* d_out, int out_size, void* d_ws,
                              size_t ws_size, hipStream_t stream) {
  static int grid_blocks = 0;
  if (!grid_blocks) {
    int dev = 0, cus = 0, per_cu = 0;
    (void)hipGetDevice(&dev);
    (void)hipDeviceGetAttribute(&cus, hipDeviceAttributeMultiprocessorCount, dev);
    (void)hipFuncSetAttribute((const void*)mega_kernel, hipFuncAttributeMaxDynamicSharedMemorySize, SMEM_BYTES);
    (void)hipOccupancyMaxActiveBlocksPerMultiprocessor(&per_cu, mega_kernel, 512, SMEM_BYTES);
    if (per_cu > 1) per_cu = 1;
    if (per_cu < 1) per_cu = 1;
    grid_blocks = cus * per_cu;
  }
  Params p;
  memset(&p, 0, sizeof(p));
  p.x_prompt = (const float*)d_in[0];  p.x_sample = (const float*)d_in[1];
  p.c_prompt = (const float*)d_in[2];  p.c_sample = (const float*)d_in[3];
  p.w_ada = (const float*)d_in[4];     p.b_ada = (const float*)d_in[5];
  p.g_pre = (const float*)d_in[6];     p.g_post = (const float*)d_in[7];
  p.w_in = (const float*)d_in[8];      p.g_q = (const float*)d_in[9];
  p.w_uq = (const float*)d_in[10];     p.g_kv = (const float*)d_in[11];
  p.w_ukv = (const float*)d_in[12];    p.rpb = (const float*)d_in[13];
  p.w_pa = (const float*)d_in[14];     p.w_pb = (const float*)d_in[15];
  p.w_pc = (const float*)d_in[16];     p.w_out = (const float*)d_in[17];
  p.out = (float*)d_out;
  p.ws = (char*)d_ws;
  if (WS_NEEDED > ws_size) fprintf(stderr, "workspace too small: need %zu have %zu\n", (size_t)WS_NEEDED, ws_size);
  (void)hipMemsetAsync((char*)d_ws + OFF_BAR, 0, BAR_BYTES, stream);
  void* args[] = {&p};
  hipError_t e = hipLaunchCooperativeKernel((void*)mega_kernel, dim3(grid_blocks), dim3(512), args, SMEM_BYTES, stream);
  if (e != hipSuccess) fprintf(stderr, "cooperative launch failed: %s (grid %d)\n", hipGetErrorString(e), grid_blocks);
}
```
